# Optimizing an MI355X kernel written in HIP

```python
import jax, jax.numpy as jnp
from jax import lax
import numpy as np

D_MODEL = 2048
BATCH = 1
SEQ = 8192
DEPTH = 1

N_SUB = 3
D_FF = 5632
POOL_WINDOWS = (2, 4, 8, 16)
POOL_GROUPS = len(POOL_WINDOWS)
POOL_GROUP_W = D_MODEL // 8
POOL_W = POOL_GROUPS * POOL_GROUP_W
HEAD_DIM = 64
N_HEADS = 16
N_KV_HEADS = 2
GQA_GROUP = N_HEADS // N_KV_HEADS
WINDOW = 128
BLK = 128
NUM_BUCKETS = 32
MAX_EXACT = NUM_BUCKETS // 2
REL_MAX_DIST = 128
EPS = 1e-6
NEG_INF = -1e30
IN_SPLITS = (POOL_W, N_HEADS * HEAD_DIM, N_KV_HEADS * HEAD_DIM, N_KV_HEADS * HEAD_DIM, D_MODEL, D_MODEL)
IN_W = sum(IN_SPLITS)

kernel_name = "hybrid_pool_swa_gated_macaron_block"


def rms_norm(x, g):
    xf = x.astype(jnp.float32)
    y = xf * lax.rsqrt(jnp.mean(xf * xf, axis=-1, keepdims=True) + EPS)
    return (y * g.astype(jnp.float32)).astype(x.dtype)


def modulate(h, shift, scale):
    return h * (1 + scale) + shift


def swiglu(h, w_gu, w_down):
    g, u = jnp.split(h @ w_gu, 2, axis=-1)
    return (jax.nn.silu(g) * u) @ w_down


def multiscale_pool(u, pool_mix, pool_scale):
    B, S, _ = u.shape
    uf = u.astype(jnp.float32).reshape(B, S, POOL_GROUPS, POOL_GROUP_W)
    cs = jnp.pad(jnp.cumsum(uf, axis=1), ((0, 0), (1, 0), (0, 0), (0, 0)))
    t1 = np.arange(1, S + 1)
    outs = []
    for gi, w in enumerate(POOL_WINDOWS):
        lo = np.maximum(t1 - w, 0)
        cnt = np.minimum(t1, w).astype(np.float32)[None, :, None]
        win_sum = cs[:, 1:, gi] - cs[:, lo, gi]
        outs.append(win_sum / cnt - uf[:, :, gi])
    pooled = jnp.stack(outs, axis=2).astype(u.dtype)
    mixed = jnp.einsum('bsgc,gcd->bsgd', pooled, pool_mix)
    return mixed.reshape(B, S, POOL_W) * pool_scale


def rel_bucket_band():
    ql = np.arange(BLK)[:, None]
    j = np.arange(2 * BLK)[None, :]
    n = np.clip(BLK + ql - j, 0, None)
    nf = np.maximum(n, 1).astype(np.float32)
    large = MAX_EXACT + (np.log(nf / MAX_EXACT) / np.log(REL_MAX_DIST / MAX_EXACT)
                         * (NUM_BUCKETS - MAX_EXACT)).astype(np.int32)
    large = np.minimum(large, NUM_BUCKETS - 1)
    return np.where(n < MAX_EXACT, n, large).astype(np.int32)


def band_mask(nb):
    qpos = (np.arange(nb)[:, None, None] * BLK + np.arange(BLK)[None, :, None])
    kpos = ((np.arange(nb)[:, None, None] - 1) * BLK + np.arange(2 * BLK)[None, None, :])
    dist = qpos - kpos
    return (dist >= 0) & (dist < WINDOW) & (kpos >= 0)


def swa_sink_attention(q, k, v, q_gain, k_gain, sinks, rel_bias):
    B, S = q.shape[:2]
    nb = S // BLK
    q = rms_norm(q, q_gain)
    k = rms_norm(k, k_gain)
    qb = q.reshape(B, nb, BLK, N_KV_HEADS, GQA_GROUP, HEAD_DIM)

    def band(t):
        tb = t.reshape(B, nb, BLK, N_KV_HEADS, HEAD_DIM)
        prev = jnp.pad(tb, ((0, 0), (1, 0), (0, 0), (0, 0), (0, 0)))[:, :nb]
        return jnp.concatenate([prev, tb], axis=2)

    kband, vband = band(k), band(v)
    logits = jnp.einsum('bnqkgd,bnjkd->bnkgqj', qb, kband).astype(jnp.float32) * (HEAD_DIM ** -0.5)
    bias = rel_bias.astype(jnp.float32)[rel_bucket_band()]
    bias = jnp.transpose(bias, (2, 0, 1)).reshape(N_KV_HEADS, GQA_GROUP, BLK, 2 * BLK)
    logits = logits + bias
    mask = band_mask(nb)[None, :, None, None]
    logits = jnp.where(mask, logits, NEG_INF)
    sink = jnp.broadcast_to(sinks.astype(jnp.float32).reshape(1, 1, N_KV_HEADS, GQA_GROUP, 1, 1),
                            logits.shape[:-1] + (1,))
    p = jax.nn.softmax(jnp.concatenate([logits, sink], axis=-1), axis=-1)[..., :-1]
    out = jnp.einsum('bnkgqj,bnjkd->bnqkgd', p.astype(v.dtype), vband)
    return out.reshape(B, S, N_HEADS * HEAD_DIM)


def setup_inputs(seed: int = 0) -> dict:
    key = jax.random.key(seed)
    ks = jax.random.split(key, 24)
    L = DEPTH

    def dense(k, shape, fan_in):
        return jax.random.normal(k, shape, jnp.float32) * (fan_in ** -0.5)

    def gain(k, shape, s=0.05):
        return 1.0 + s * jax.random.normal(k, shape, jnp.float32)

    return {
        "x": jax.random.normal(ks[0], (BATCH, SEQ, D_MODEL), jnp.float32),
        "c": jax.random.normal(ks[1], (BATCH, D_MODEL), jnp.float32),
        "w_ada": dense(ks[2], (L, D_MODEL, 3 * N_SUB * D_MODEL), D_MODEL),
        "b_ada": 0.02 * jax.random.normal(ks[3], (L, 3 * N_SUB * D_MODEL), jnp.float32),
        "g_ffn1": gain(ks[4], (L, D_MODEL)),
        "w_ffn1_gu": dense(ks[5], (L, D_MODEL, 2 * D_FF), D_MODEL),
        "w_ffn1_down": dense(ks[6], (L, D_FF, D_MODEL), D_FF),
        "g_mix": gain(ks[7], (L, D_MODEL)),
        "w_in": dense(ks[8], (L, D_MODEL, IN_W), D_MODEL),
        "pool_mix": dense(ks[9], (L, POOL_GROUPS, POOL_GROUP_W, POOL_GROUP_W), POOL_GROUP_W),
        "pool_scale": gain(ks[10], (L, POOL_W), 0.1),
        "w_pool_up": dense(ks[11], (L, POOL_W, D_MODEL), POOL_W),
        "q_gain": gain(ks[12], (L, HEAD_DIM)),
        "k_gain": gain(ks[13], (L, HEAD_DIM)),
        "sinks": jax.random.normal(ks[14], (L, N_HEADS), jnp.float32),
        "rel_bias": 0.5 * jax.random.normal(ks[15], (NUM_BUCKETS, N_HEADS), jnp.float32),
        "w_attn_up": dense(ks[16], (L, N_HEADS * HEAD_DIM, D_MODEL), N_HEADS * HEAD_DIM),
        "w_o": dense(ks[17], (L, D_MODEL, D_MODEL), D_MODEL),
        "g_ffn2": gain(ks[18], (L, D_MODEL)),
        "w_ffn2_gu": dense(ks[19], (L, D_MODEL, 2 * D_FF), D_MODEL),
        "w_ffn2_down": dense(ks[20], (L, D_FF, D_MODEL), D_FF),
    }


def reference(x, c, w_ada, b_ada, g_ffn1, w_ffn1_gu, w_ffn1_down, g_mix, w_in, pool_mix,
              pool_scale, w_pool_up, q_gain, k_gain, sinks, rel_bias, w_attn_up, w_o,
              g_ffn2, w_ffn2_gu, w_ffn2_down):
    B, S, D = x.shape
    split_idx = [int(s) for s in np.cumsum(IN_SPLITS)[:-1]]
    for l in range(DEPTH):
        mod = (jax.nn.silu(c) @ w_ada[l] + b_ada[l]).reshape(B, 3 * N_SUB, 1, D)

        h = modulate(rms_norm(x, g_ffn1[l]), mod[:, 0], mod[:, 1])
        x = x + 0.5 * mod[:, 2] * swiglu(h, w_ffn1_gu[l], w_ffn1_down[l])

        h = modulate(rms_norm(x, g_mix[l]), mod[:, 3], mod[:, 4])
        z = h @ w_in[l]
        u_pool, q, k, v, ga, gb = jnp.split(z, split_idx, axis=-1)
        y_pool = multiscale_pool(u_pool, pool_mix[l], pool_scale[l]) @ w_pool_up[l]
        y_attn = swa_sink_attention(
            q.reshape(B, S, N_HEADS, HEAD_DIM),
            k.reshape(B, S, N_KV_HEADS, HEAD_DIM),
            v.reshape(B, S, N_KV_HEADS, HEAD_DIM),
            q_gain[l], k_gain[l], sinks[l], rel_bias) @ w_attn_up[l]
        merged = jax.nn.sigmoid(ga) * y_pool + jax.nn.sigmoid(gb) * y_attn
        x = x + mod[:, 5] * (merged @ w_o[l])

        h = modulate(rms_norm(x, g_ffn2[l]), mod[:, 6], mod[:, 7])
        x = x + 0.5 * mod[:, 8] * swiglu(h, w_ffn2_gu[l], w_ffn2_down[l])
    return x
```

```cpp
#include <hip/hip_runtime.h>
#include <cstdio>
#include <cstdint>


#ifndef PHASE_MASK
#define PHASE_MASK 0xFFFF
#endif
#define LAS __attribute__((address_space(3)))
typedef unsigned short bf16;
typedef short bf16x8 __attribute__((ext_vector_type(8)));
typedef short s16x4 __attribute__((ext_vector_type(4)));
typedef float f32x4 __attribute__((ext_vector_type(4)));
typedef float f32x2 __attribute__((ext_vector_type(2)));
typedef unsigned u32x4 __attribute__((ext_vector_type(4)));
typedef unsigned u32x2 __attribute__((ext_vector_type(2)));
typedef __bf16 bf16x2_t __attribute__((ext_vector_type(2)));

__device__ __forceinline__ unsigned pk2(float lo, float hi) { f32x2 v = {lo, hi}; bf16x2_t b = __builtin_convertvector(v, bf16x2_t); return __builtin_bit_cast(unsigned, b); }
__device__ __forceinline__ float bflo(unsigned w) { return __uint_as_float(w << 16); }
__device__ __forceinline__ float bfhi(unsigned w) { return __uint_as_float(w & 0xffff0000u); }
__device__ __forceinline__ float sigmoid_f(float x) { return __builtin_amdgcn_rcpf(1.f + __builtin_amdgcn_exp2f(-1.4426950408889634f * x)); }

constexpr int S = 8192, D = 2048, FF = 5632, INW = 6400, PW = 1024, AW = 1024, KVW = 128, NH = 16, HD = 64;
constexpr int LDP = D + 64;
constexpr int NMOD = 9 * D;
constexpr float EPS = 1e-6f;
constexpr float LOG2E = 1.4426950408889634f;

constexpr size_t MiB = 1u << 20;
constexpr size_t WS_CTL = 0, CTL_ZERO_BYTES = 64 * 1024;
constexpr size_t WS_MODP = 1 * MiB;
constexpr size_t WS_MOD = 2 * MiB + 512 * 1024;
constexpr size_t WS_BWIN = WS_MOD + 128 * 1024, WS_BWGU = WS_MOD + 192 * 1024;
constexpr size_t WS_ROWP = 3 * MiB;
constexpr size_t WS_BPIN = 4 * MiB;
constexpr size_t WS_BPGU = 5 * MiB;
constexpr size_t WS_WGU1 = 8 * MiB;
constexpr size_t WS_WD1 = WS_WGU1 + 46 * MiB;
constexpr size_t WS_WIN = WS_WD1 + 22 * MiB;
constexpr size_t WS_WPM = WS_WIN + 26 * MiB;
constexpr size_t WS_WPU = WS_WPM + 1 * MiB;
constexpr size_t WS_WAU = WS_WPU + 4 * MiB;
constexpr size_t WS_WO = WS_WAU + 4 * MiB;
constexpr size_t WS_WGU2 = WS_WO + 9 * MiB;
constexpr size_t WS_WD2 = WS_WGU2 + 46 * MiB;
constexpr size_t WS_H = WS_WD2 + 22 * MiB;
constexpr size_t WS_BIG = WS_H + 34 * MiB;
constexpr size_t WS_ACT = WS_BIG;
constexpr size_t WS_U = WS_BIG;
constexpr size_t WS_Q = WS_U + 32 * MiB;
constexpr size_t WS_K = WS_Q + 16 * MiB;
constexpr size_t WS_V = WS_K + 2 * MiB;
constexpr size_t WS_GA = WS_V + 2 * MiB;
constexpr size_t WS_GB = WS_GA + 32 * MiB;
constexpr size_t WS_POOLED = WS_GB + 32 * MiB;
constexpr size_t WS_MIXED = WS_POOLED + 16 * MiB;
constexpr size_t WS_ATT = WS_MIXED + 16 * MiB;
constexpr size_t WS_MERGED = WS_ATT + 16 * MiB;
constexpr size_t WS_HX = WS_MERGED + 34 * MiB;
constexpr size_t WS_END = WS_HX + 34 * MiB;
static_assert(WS_ACT + (size_t)S * FF * 2 <= WS_END, "act fits in the big region");
constexpr int CW_BAR = 1024, CW_QHEAD = 8192, CW_CVDONE = 8256, CW_PANEL = 12288;

namespace pg8 {
constexpr int BM = 256, BK = 64, HALF = 128, HTB = HALF * BK * 2, STAGE_BYTES = 8 * HTB, NXCD = 8, WGM = 8;
__device__ __forceinline__ int lds_byte(int r, int c) { const int st = (r >> 4) * 2 + (c >> 5), rr = r & 15, cc = c & 31, ob = rr * 64 + cc * 2; return st * 1024 + (ob ^ (((ob >> 9) & 1) << 5)); }
__device__ __forceinline__ void stage_rc(int b, int& R, int& C) { const int st = b / 1024, sb = b % 1024, swz = sb ^ (((sb >> 9) & 1) << 5); R = (st >> 1) * 16 + swz / 64; C = (st & 1) * 32 + (swz % 64) / 2; }
__device__ __forceinline__ int perm32(int rho) { const int n = rho >> 4, i = rho & 15; return 8 * (i >> 2) + 4 * n + (i & 3); }

struct Unit { int pm, pn, kind, rowbase, halfm; const char* A; const char* B; };

struct Sched {
    int split_round, split_mod;
    int nM, nN, nwg, G, c, dual, r_lo, r_hi, mode;
    const char *A0, *B0, *A1, *B1; size_t a_tile, b_tile, a_pn;
    __device__ __forceinline__ void init(int M, int N, int G_, int c_, const void* A0_, const void* B0_, size_t lda, size_t ldb, size_t a_pn_bytes = 0, const void* A1_ = nullptr, const void* B1_ = nullptr) {
        nM = M / BM; nN = N / BM; nwg = nM * nN; G = G_; c = c_; dual = (A1_ != nullptr); r_lo = 0; r_hi = 1 << 30; mode = 0; split_round = 1 << 30; split_mod = 1;
        A0 = (const char*)A0_; B0 = (const char*)B0_; A1 = (const char*)A1_; B1 = (const char*)B1_;
        a_tile = (size_t)BM * lda * 2; b_tile = (size_t)BM * ldb * 2; a_pn = a_pn_bytes;
    }
    __device__ __forceinline__ bool next(int i, Unit& u) const {
        const int ti = (dual ? (i >> 1) : i) + r_lo; if (ti >= r_hi || ti > split_round) return false;
        const bool hs = (ti == split_round);
        const long L = (long)ti * G + (hs ? c % split_mod : c); if (L >= nwg) return false;
        u.halfm = hs ? 1 : 0;
        if (mode == 2) {
            if (i > 0) return false;
            const int x = c & 7, j = c >> 3, early = j >= 16 ? 1 : 0, jj = j & 15;
            u.pm = 8 * (x >> 1) + (early ? 0 : 4) + 2 * (x & 1) + (jj >> 3); u.pn = jj & 7;
        } else {
        int wgid = (int)L; { const int q = nwg / NXCD, r = nwg % NXCD, xcd = wgid % NXCD, off = wgid / NXCD; wgid = (xcd < r ? xcd * (q + 1) : r * (q + 1) + (xcd - r) * q) + off; }
        const int nig = WGM * nN, gid = wgid / nig, fm = gid * WGM, gsz = (nM - fm) < WGM ? (nM - fm) : WGM;
        if (mode == 1) {
            const int idx = wgid % nig, hf = idx / 176, off = idx % 176, sec = off / 88, o2 = off % 88;
            u.pm = fm + 4 * sec + (o2 & 3); u.pn = 22 * hf + (o2 >> 2);
        } else { u.pm = fm + ((wgid % nig) % gsz); u.pn = (wgid % nig) / gsz; }
        }
        const int sub = dual ? (i & 1) : 0; u.kind = dual ? (1 + sub) : 0;
        u.rowbase = u.pm * BM + (hs ? (c / split_mod) * HALF : 0);
        u.A = (sub ? A1 : A0) + (size_t)u.pm * a_tile + (size_t)u.pn * a_pn + (hs ? (size_t)(c / split_mod) * (a_tile / 2) : 0);
        u.B = (sub ? B1 : B0) + (size_t)u.pn * b_tile;
        return true;
    }
};

template <class Epi, bool ALIGN_EPI, bool PUB = false>
__device__ __forceinline__ void gemm_phase(LAS unsigned char* lds, const int K, const int lda, const int ldb, const Sched& S, const Epi& E, unsigned* ctr = nullptr) {
    int tid_ = threadIdx.x; asm volatile("" : "+v"(tid_));
    const int tid = tid_, wid = __builtin_amdgcn_readfirstlane(tid >> 6), lane = tid & 63, wr = wid >> 2, wc = wid & 3, fr = lane & 15, fq = lane >> 4;
    const int nt = K / BK;
    unsigned voffA[2], voffB[2];
#pragma unroll
    for (int i = 0; i < 2; ++i) { int R, C; stage_rc(tid * 16 + i * 8192, R, C); const int Rb = (R & ~31) + perm32(R & 31);
        voffA[i] = (unsigned)(R * lda + C) * 2u; voffB[i] = (unsigned)(Rb * ldb + C) * 2u; }
    const size_t kstep = (size_t)(BK * 2);
    const size_t hstepA_full = (size_t)HALF * lda * 2, hstepB = (size_t)HALF * ldb * 2;
    const unsigned ldsw = (unsigned)wid * 1024u;
    const int aoff = lds_byte(wr * 64 + fr, fq * 8), boff = lds_byte(wc * 32 + fr, fq * 8);
#define PG8_SA(b, h) (((b) * 2 + (h)) * HTB)
#define PG8_SB(b, h) ((4 + (b) * 2 + (h)) * HTB)
#define PG8_STAGE(bufoff, gbase, voff) do { _Pragma("unroll") for (int _i = 0; _i < 2; ++_i) \
        __builtin_amdgcn_global_load_lds((const unsigned*)((const char*)(gbase) + (voff)[_i]), (LAS unsigned*)(lds + (bufoff) + ldsw + _i * 8192), 16, 0, 0); } while (0)
#define PG8_LDA(dst, b, h) do { _Pragma("unroll") for (int m = 0; m < 4; ++m) _Pragma("unroll") for (int k = 0; k < 2; ++k) dst[m][k] = *(const LAS bf16x8*)(lds + PG8_SA(b, h) + aoff + m * 2048 + k * 1024); } while (0)
#define PG8_LDB(dst, b, h) do { _Pragma("unroll") for (int n = 0; n < 2; ++n) _Pragma("unroll") for (int k = 0; k < 2; ++k) dst[n][k] = *(const LAS bf16x8*)(lds + PG8_SB(b, h) + boff + n * 2048 + k * 1024); } while (0)
#define PG8_MMA(ai, bj, At, Bt) do { __builtin_amdgcn_s_setprio(1); _Pragma("unroll") for (int m = 0; m < 4; ++m) _Pragma("unroll") for (int n = 0; n < 2; ++n) _Pragma("unroll") for (int k = 0; k < 2; ++k) \
        acc[ai][bj][m][n] = __builtin_amdgcn_mfma_f32_16x16x32_bf16(Bt[n][k], At[m][k], acc[ai][bj][m][n], 0, 0, 0); __builtin_amdgcn_s_setprio(0); } while (0)
#define PG8_WAIT_V(n) asm volatile("s_waitcnt vmcnt(" #n ")" ::: "memory")
#define PG8_WAIT_L(n) asm volatile("s_waitcnt lgkmcnt(" #n ")" ::: "memory")
#define PG8_BAR __builtin_amdgcn_s_barrier()
#define PG8_SCHED __builtin_amdgcn_sched_barrier(0)
    Unit cur, nxt; int ui = 0; int pend_pm = -1; unsigned pend_n = 0u;
    if (!S.next(0, cur)) return;
    f32x4 acc[2][2][4][2];
#pragma unroll
    for (int a = 0; a < 2; ++a)
#pragma unroll
        for (int b = 0; b < 2; ++b)
#pragma unroll
            for (int m = 0; m < 4; ++m)
#pragma unroll
                for (int n = 0; n < 2; ++n) acc[a][b][m][n] = (f32x4){0.f, 0.f, 0.f, 0.f};
    bf16x8 At[4][2], B0[2][2], B1[2][2];
    const char* cA = cur.A; const char* cB = cur.B;
    size_t hstepA = cur.halfm ? 0 : hstepA_full;
    PG8_STAGE(PG8_SB(0, 0), cB, voffB); PG8_STAGE(PG8_SB(0, 1), cB + hstepB, voffB); PG8_STAGE(PG8_SA(0, 0), cA, voffA); PG8_STAGE(PG8_SA(0, 1), cA + hstepA, voffA);
    if (wr == 1) PG8_BAR;
    PG8_WAIT_V(2); PG8_BAR;
    PG8_STAGE(PG8_SB(1, 0), cB + kstep, voffB); PG8_STAGE(PG8_SA(1, 0), cA + kstep, voffA); PG8_STAGE(PG8_SB(1, 1), cB + hstepB + kstep, voffB);
    PG8_WAIT_V(6); PG8_BAR;
    for (;;) {
        const bool has_next = S.next(ui + 1, nxt);
        const char* nA = has_next ? nxt.A : cA; const char* nB = has_next ? nxt.B : cB;
        const size_t hstepA_n = has_next ? (nxt.halfm ? 0 : hstepA_full) : hstepA; const bool fullm = !cur.halfm;
#pragma unroll 1
        for (int t = 0; t < nt; t += 2) {
            const bool last = (t == nt - 2);
            const char* a1 = cA + (size_t)(t + 1) * kstep;
            const char* a2 = last ? nA : cA + (size_t)(t + 2) * kstep; const char* b2 = last ? nB : cB + (size_t)(t + 2) * kstep;
            const char* a3 = a2 + kstep; const char* b3 = b2 + kstep;
            PG8_LDB(B0, 0, 0); PG8_LDB(B1, 0, 1); PG8_SCHED; PG8_LDA(At, 0, 0); PG8_STAGE(PG8_SA(1, 1), a1 + hstepA, voffA);
            PG8_WAIT_V(8); PG8_WAIT_L(0); PG8_BAR; PG8_MMA(0, 0, At, B0); PG8_MMA(0, 1, At, B1); PG8_BAR; PG8_SCHED;
            if (fullm) PG8_LDA(At, 0, 1); PG8_STAGE(PG8_SB(0, 0), b2, voffB); PG8_STAGE(PG8_SB(0, 1), b2 + hstepB, voffB); PG8_STAGE(PG8_SA(0, 0), a2, voffA);
            PG8_WAIT_V(8); PG8_WAIT_L(0); PG8_BAR; if (fullm) { PG8_MMA(1, 0, At, B0); PG8_MMA(1, 1, At, B1); } PG8_BAR; PG8_SCHED;
            PG8_LDB(B0, 1, 0); PG8_LDB(B1, 1, 1); PG8_SCHED; PG8_LDA(At, 1, 0); PG8_STAGE(PG8_SA(0, 1), a2 + (last ? hstepA_n : hstepA), voffA);
            PG8_WAIT_V(8); PG8_WAIT_L(0); PG8_BAR; PG8_MMA(0, 0, At, B0); PG8_MMA(0, 1, At, B1); PG8_BAR; PG8_SCHED;
            if (fullm) PG8_LDA(At, 1, 1); PG8_STAGE(PG8_SB(1, 0), b3, voffB); PG8_STAGE(PG8_SB(1, 1), b3 + hstepB, voffB); PG8_STAGE(PG8_SA(1, 0), a3, voffA);
            PG8_WAIT_V(8); PG8_WAIT_L(0); PG8_BAR; if (fullm) { PG8_MMA(1, 0, At, B0); PG8_MMA(1, 1, At, B1); } PG8_BAR; PG8_SCHED;
        }
        if constexpr (ALIGN_EPI) { if (wr == 0) PG8_BAR; }
        if constexpr (PUB) {
            if (pend_n != 0u && cur.pm != pend_pm) { PG8_WAIT_V(0); if (lane == 0) __hip_atomic_fetch_add(ctr + 64 * pend_pm, pend_n, __ATOMIC_RELAXED, __HIP_MEMORY_SCOPE_AGENT); pend_n = 0u; }
            pend_pm = cur.pm; pend_n += cur.halfm ? 1u : 2u; }
        const bool keep = E(acc, cur, wr, wc, fr, fq);
        if (!has_next) break;
        if (!keep) {
#pragma unroll
            for (int a = 0; a < 2; ++a)
#pragma unroll
                for (int b = 0; b < 2; ++b)
#pragma unroll
                    for (int m = 0; m < 4; ++m)
#pragma unroll
                        for (int n = 0; n < 2; ++n) acc[a][b][m][n] = (f32x4){0.f, 0.f, 0.f, 0.f};
        }
        cur = nxt; cA = nA; cB = nB; hstepA = hstepA_n; ++ui;
        if constexpr (ALIGN_EPI) { if (wr == 1) PG8_BAR; }
    }
    PG8_WAIT_V(0);
    if constexpr (PUB) { if (pend_n != 0u && lane == 0) __hip_atomic_fetch_add(ctr + 64 * pend_pm, pend_n, __ATOMIC_RELAXED, __HIP_MEMORY_SCOPE_AGENT); }
    if constexpr (!ALIGN_EPI) { if (wr == 0) PG8_BAR; }
    PG8_BAR;
#undef PG8_SA
#undef PG8_SB
#undef PG8_STAGE
#undef PG8_LDA
#undef PG8_LDB
#undef PG8_MMA
#undef PG8_WAIT_V
#undef PG8_WAIT_L
#undef PG8_BAR
#undef PG8_SCHED
}

typedef f32x4 (&AccRef)[2][2][4][2];
__device__ __forceinline__ u32x4 pack8(const f32x4 v0, const f32x4 v1) { u32x4 w; w.x = pk2(v0[0], v0[1]); w.y = pk2(v0[2], v0[3]); w.z = pk2(v1[0], v1[1]); w.w = pk2(v1[2], v1[3]); return w; }

__device__ __forceinline__ float row_rstd(const float* rowpart, int row) {
    const f32x4* p = (const f32x4*)(rowpart + (size_t)row * 32);
    f32x4 s4 = p[0];
#pragma unroll
    for (int i = 1; i < 8; ++i) s4 += p[i];
    return 1.0f / sqrtf(((s4[0] + s4[1]) + (s4[2] + s4[3])) * (1.0f / D) + EPS);
}
__device__ __forceinline__ void apply_rs_bias(AccRef acc, const float* rowpart, int rowbase, int fr, const float* bias, int bcol0, int halfm) {
    const int lane = threadIdx.x & 63;
    f32x4 bv[2][2];
#pragma unroll
    for (int bj = 0; bj < 2; ++bj)
#pragma unroll
        for (int n = 0; n < 2; ++n) bv[bj][n] = *(const f32x4*)(bias + bcol0 + bj * HALF + 4 * n);
    float rv[2];
    rv[0] = row_rstd(rowpart, rowbase + lane); rv[1] = halfm ? 1.0f : row_rstd(rowpart, rowbase + HALF + lane);
#pragma unroll
    for (int ai = 0; ai < 2; ++ai)
#pragma unroll
        for (int m = 0; m < 4; ++m) { const float rs = __shfl(rv[ai], m * 16 + fr);
#pragma unroll
            for (int bj = 0; bj < 2; ++bj)
#pragma unroll
                for (int n = 0; n < 2; ++n) acc[ai][bj][m][n] = acc[ai][bj][m][n] * rs + bv[bj][n]; }
}
template <bool NORM> struct EpiSwiglu {
    bf16* O; int ldc; const float* rowpart; const float* bias;
    __device__ __forceinline__ bool operator()(AccRef acc, const Unit& u, int wr, int wc, int fr, int fq) const {
        const int row0 = u.rowbase + wr * 64 + fr, col0 = u.pn * HALF + wc * 32 + 8 * fq;
        if constexpr (NORM) apply_rs_bias(acc, rowpart, u.rowbase + wr * 64, fr, bias, u.pn * BM + wc * 32 + 8 * fq, u.halfm);
        const __amdgpu_buffer_rsrc_t rs_o = __builtin_amdgcn_make_buffer_rsrc(O, 0, S * FF * 2, 0x00020000);
#pragma unroll
        for (int ai = 0; ai < 2; ++ai) if (!(ai == 1 && u.halfm))
#pragma unroll
            for (int m = 0; m < 4; ++m) {
                f32x4 o[2];
#pragma unroll
                for (int n = 0; n < 2; ++n) { const f32x4 g = acc[ai][0][m][n], up = acc[ai][1][m][n];
#pragma unroll
                    for (int j = 0; j < 4; ++j) o[n][j] = g[j] * up[j] * sigmoid_f(g[j]); }
                __builtin_amdgcn_raw_buffer_store_b128(pack8(o[0], o[1]), rs_o, (unsigned)(((row0 + ai * HALF + m * 16) * ldc + col0) * 2), 0,   16);
            }
        return false;
    }
};
template <bool NEXT, bool HALFG> struct EpiResid {
    static constexpr float gsc = HALFG ? 0.5f : 1.0f;
    const float* base; float* out; const float* gate; const float* gn; const float* scn; bf16* XA; float* rowpart;
    __device__ __forceinline__ bool operator()(AccRef acc, const Unit& u, int wr, int wc, int fr, int fq) const {
        const int row0 = u.rowbase + wr * 64 + fr, col0 = u.pn * BM + wc * 32 + 8 * fq;
        f32x4 gv[2][2], an[2][2];
#pragma unroll
        for (int bj = 0; bj < 2; ++bj)
#pragma unroll
            for (int n = 0; n < 2; ++n) { gv[bj][n] = *(const f32x4*)(gate + col0 + bj * HALF + 4 * n) * gsc;
                if constexpr (NEXT) an[bj][n] = *(const f32x4*)(gn + col0 + bj * HALF + 4 * n) * (*(const f32x4*)(scn + col0 + bj * HALF + 4 * n) + 1.0f); }
#pragma unroll
        for (int ai = 0; ai < 2; ++ai)
#pragma unroll
            for (int m = 0; m < 4; ++m) { const int row = row0 + ai * HALF + m * 16; const size_t off = (size_t)row * D + col0; float ss = 0.f;
#pragma unroll
                for (int bj = 0; bj < 2; ++bj) {
                    const f32x4 b0 = *(const f32x4*)(base + off + bj * HALF), b1 = *(const f32x4*)(base + off + bj * HALF + 4);
                    const f32x4 x0 = b0 + gv[bj][0] * acc[ai][bj][m][0], x1 = b1 + gv[bj][1] * acc[ai][bj][m][1];
                    *(f32x4*)(out + off + bj * HALF) = x0; *(f32x4*)(out + off + bj * HALF + 4) = x1;
                    if constexpr (NEXT) {
                        ss += ((x0[0] * x0[0] + x0[1] * x0[1]) + (x0[2] * x0[2] + x0[3] * x0[3])) + ((x1[0] * x1[0] + x1[1] * x1[1]) + (x1[2] * x1[2] + x1[3] * x1[3]));
                        *(u32x4*)(XA + (size_t)row * LDP + col0 + bj * HALF) = pack8(x0 * an[bj][0], x1 * an[bj][1]); } }
                if constexpr (NEXT) { ss += __shfl_xor(ss, 16); ss += __shfl_xor(ss, 32); if (fq == 0) rowpart[(size_t)row * 32 + u.pn * 4 + wc] = ss; }
                if (m & 1) asm volatile("" ::: "memory"); }
        return false;
    }
};
struct EpiIn {
    float* U; bf16* Q; bf16* Kb; bf16* Vb; bf16* GA; bf16* GB; const float* rowpart; const float* bias;
    __device__ __forceinline__ bool operator()(AccRef acc, const Unit& u, int wr, int wc, int fr, int fq) const {
        const int row0 = u.rowbase + wr * 64 + fr, cw = wc * 32 + 8 * fq; const int pn = u.pn;
        apply_rs_bias(acc, rowpart, u.rowbase + wr * 64, fr, bias, pn * BM + cw, u.halfm);
        if (pn < 4) {
#pragma unroll
            for (int ai = 0; ai < 2; ++ai) if (!(ai == 1 && u.halfm))
#pragma unroll
                for (int m = 0; m < 4; ++m) { float* rp = U + (size_t)(row0 + ai * HALF + m * 16) * PW + pn * BM + cw;
#pragma unroll
                    for (int bj = 0; bj < 2; ++bj) { *(f32x4*)(rp + bj * HALF) = acc[ai][bj][m][0]; *(f32x4*)(rp + bj * HALF + 4) = acc[ai][bj][m][1]; } }
        } else if (pn < 8) {
#pragma unroll
            for (int ai = 0; ai < 2; ++ai) if (!(ai == 1 && u.halfm))
#pragma unroll
                for (int m = 0; m < 4; ++m) { bf16* rp = Q + (size_t)(row0 + ai * HALF + m * 16) * AW + (pn - 4) * BM + cw;
#pragma unroll
                    for (int bj = 0; bj < 2; ++bj) *(u32x4*)(rp + bj * HALF) = pack8(acc[ai][bj][m][0], acc[ai][bj][m][1]); }
        } else if (pn == 8) {
#pragma unroll
            for (int ai = 0; ai < 2; ++ai) if (!(ai == 1 && u.halfm))
#pragma unroll
                for (int m = 0; m < 4; ++m) { const size_t ro = (size_t)(row0 + ai * HALF + m * 16) * KVW + cw;
                    *(u32x4*)(Kb + ro) = pack8(acc[ai][0][m][0], acc[ai][0][m][1]); *(u32x4*)(Vb + ro) = pack8(acc[ai][1][m][0], acc[ai][1][m][1]); }
        } else {
            const int ct = (pn - 9) * HALF + cw;
#pragma unroll
            for (int ai = 0; ai < 2; ++ai) if (!(ai == 1 && u.halfm))
#pragma unroll
                for (int m = 0; m < 4; ++m) { const size_t ro = (size_t)(row0 + ai * HALF + m * 16) * D + ct; f32x4 r0, r1, s0, s1;
#pragma unroll
                    for (int j = 0; j < 4; ++j) {
                        const float ea0 = __builtin_amdgcn_exp2f(-LOG2E * acc[ai][0][m][0][j]), eb0 = __builtin_amdgcn_exp2f(-LOG2E * acc[ai][1][m][0][j]);
                        const float ea1 = __builtin_amdgcn_exp2f(-LOG2E * acc[ai][0][m][1][j]), eb1 = __builtin_amdgcn_exp2f(-LOG2E * acc[ai][1][m][1][j]);
                        s0[j] = fmaxf(__builtin_amdgcn_rcpf(1.f + eb0), 1e-30f); s1[j] = fmaxf(__builtin_amdgcn_rcpf(1.f + eb1), 1e-30f);
                        r0[j] = __builtin_amdgcn_rcpf(1.f + ea0) * __builtin_amdgcn_rcpf(s0[j]); r1[j] = __builtin_amdgcn_rcpf(1.f + ea1) * __builtin_amdgcn_rcpf(s1[j]); }
                    *(u32x4*)(GA + ro) = pack8(r0, r1); *(u32x4*)(GB + ro) = pack8(s0, s1); asm volatile("" ::: "memory"); }
        }
        return false;
    }
};
struct EpiPoolMix {
    bf16* O; const float* pscale;
    __device__ __forceinline__ bool operator()(AccRef acc, const Unit& u, int wr, int wc, int fr, int fq) const {
        const int row0 = u.rowbase + wr * 64 + fr, col0 = u.pn * BM + wc * 32 + 8 * fq;
        f32x4 sv[2][2];
#pragma unroll
        for (int bj = 0; bj < 2; ++bj)
#pragma unroll
            for (int n = 0; n < 2; ++n) sv[bj][n] = *(const f32x4*)(pscale + col0 + bj * HALF + 4 * n);
#pragma unroll
        for (int ai = 0; ai < 2; ++ai)
#pragma unroll
            for (int m = 0; m < 4; ++m) { bf16* rp = O + (size_t)(row0 + ai * HALF + m * 16) * PW + col0;
#pragma unroll
                for (int bj = 0; bj < 2; ++bj) *(u32x4*)(rp + bj * HALF) = pack8(acc[ai][bj][m][0] * sv[bj][0], acc[ai][bj][m][1] * sv[bj][1]); }
        return false;
    }
};
struct EpiMerge {
    const bf16* R; const bf16* SB; bf16* O;
    __device__ __forceinline__ bool operator()(AccRef acc, const Unit& u, int wr, int wc, int fr, int fq) const {
        const int row0 = u.rowbase + wr * 64 + fr, col0 = u.pn * BM + wc * 32 + 8 * fq;
        const bool first = (u.kind == 1);
        const bf16* G = first ? R : SB;
#pragma unroll
        for (int ai = 0; ai < 2; ++ai) if (!(ai == 1 && u.halfm)) {
            u32x4 w[4][2];
#pragma unroll
            for (int m = 0; m < 4; ++m)
#pragma unroll
                for (int bj = 0; bj < 2; ++bj) w[m][bj] = *(const u32x4*)(G + (size_t)(row0 + ai * HALF + m * 16) * D + col0 + bj * HALF);
#pragma unroll
            for (int m = 0; m < 4; ++m)
#pragma unroll
                for (int bj = 0; bj < 2; ++bj) { const u32x4 wv = w[m][bj];
                    const f32x4 g0 = {bflo(wv.x), bfhi(wv.x), bflo(wv.y), bfhi(wv.y)}, g1 = {bflo(wv.z), bfhi(wv.z), bflo(wv.w), bfhi(wv.w)};
                    if (first) {
#pragma unroll
                        for (int j = 0; j < 4; ++j) { acc[ai][bj][m][0][j] *= g0[j]; acc[ai][bj][m][1][j] *= g1[j]; } }
                    else { f32x4 o0, o1;
#pragma unroll
                        for (int j = 0; j < 4; ++j) { o0[j] = acc[ai][bj][m][0][j] * g0[j]; o1[j] = acc[ai][bj][m][1][j] * g1[j]; }
                        *(u32x4*)(O + (size_t)(row0 + ai * HALF + m * 16) * LDP + col0 + bj * HALF) = pack8(o0, o1); } }
            asm volatile("" ::: "memory"); }
        return first;
    }
};
}

constexpr int RING_BYTES = 131072;
constexpr int MISC_OFF = RING_BYTES + 320;
constexpr int TAB_OFF = RING_BYTES + 1024;
constexpr int LDS_BYTES = 163840;

#define XB_TMO      128
#define XB_XCNT(j)  (256  + 64 * (j))
#define XB_XSUB(j)  (1280 + 64 * (j))
#define XB_XGEN(j)  (2304 + 64 * (j))
#define XB_TOP      3328
#define XB_TOPGEN   3392
#define XCD_BAR_WORDS 3456
#define XB_SPIN_CAP (1u << 18)
__device__ __forceinline__ unsigned xb_ld(unsigned* p)              { return __hip_atomic_load(p, __ATOMIC_RELAXED, __HIP_MEMORY_SCOPE_AGENT); }
__device__ __forceinline__ unsigned xb_add(unsigned* p, unsigned v) { return __hip_atomic_fetch_add(p, v, __ATOMIC_RELAXED, __HIP_MEMORY_SCOPE_AGENT); }
__device__ __forceinline__ unsigned xb_xcc_id() { return (unsigned)__builtin_amdgcn_s_getreg((3 << 11) | 20) & 0xFu; }
#define XB_SPIN(cond, bar) do { unsigned _sp = 0; while (cond) { __builtin_amdgcn_s_sleep(1); \
    if ((++_sp & 255u) == 0u) { if (xb_ld(&(bar)[XB_TMO])) break; if (_sp > XB_SPIN_CAP) { atomicAdd(&(bar)[XB_TMO], 1u); break; } } } } while (0)
struct XcdBarrier { unsigned* bar; unsigned x; volatile LAS unsigned* st; };
__device__ __forceinline__ XcdBarrier xcd_barrier_post(unsigned* bar, volatile LAS unsigned* st) {
    XcdBarrier b; b.bar = bar; b.x = xb_xcc_id(); b.st = st;
    if (threadIdx.x == 0) (void)xb_add(&bar[XB_XCNT(b.x)], 1u);
    return b;
}
__device__ __forceinline__ void xcd_barrier_complete(unsigned* bar, unsigned x, unsigned& nloc, unsigned& nx) {
    const unsigned G = gridDim.x * gridDim.y * gridDim.z;
    unsigned sum, cnt, mine, sp = 0u;
    for (;;) {
        sum = 0u; cnt = 0u; mine = 0u;
#pragma unroll
        for (unsigned j = 0; j < 16; ++j) { const unsigned c = xb_ld(&bar[XB_XCNT(j)]); sum += c; cnt += (c > 0u) ? 1u : 0u; mine = (j == x) ? c : mine; }
        if (sum == G) break;
        __builtin_amdgcn_s_sleep(1);
        if ((++sp & 255u) == 0u) { if (xb_ld(&bar[XB_TMO])) break; if (sp > XB_SPIN_CAP) { atomicAdd(&bar[XB_TMO], 1u); break; } }
    }
    nloc = mine > 0u ? mine : 1u; nx = cnt > 0u ? cnt : 1u;
}
__device__ __forceinline__ void xcd_barrier(const XcdBarrier& b) {
    asm volatile("s_waitcnt vmcnt(0)" ::: "memory");
    __syncthreads();
    if (threadIdx.x == 0) {
        unsigned* bar = b.bar;
        __builtin_amdgcn_s_waitcnt(0);
        unsigned nloc = b.st[0], nx = b.st[1];
        if (nloc == 0u) { xcd_barrier_complete(bar, b.x, nloc, nx); b.st[0] = nloc; b.st[1] = nx; }
        const unsigned old = xb_add(&bar[XB_XSUB(b.x)], 1u);
        const unsigned gen = old / nloc;
        if (old + 1u == (gen + 1u) * nloc) {
            __builtin_amdgcn_fence(__ATOMIC_RELEASE, "agent");
            asm volatile("s_waitcnt vmcnt(0)" ::: "memory");
            const unsigned og = xb_add(&bar[XB_TOP], 1u);
            const unsigned tg = og / nx;
            if (og + 1u == (tg + 1u) * nx) xb_add(&bar[XB_TOPGEN], 1u);
            else XB_SPIN(xb_ld(&bar[XB_TOPGEN]) == tg, bar);
            __builtin_amdgcn_fence(__ATOMIC_ACQUIRE, "agent");
            xb_add(&bar[XB_XGEN(b.x)], 1u);
            asm volatile("s_waitcnt vmcnt(0)" ::: "memory");
        } else {
            XB_SPIN(xb_ld(&bar[XB_XGEN(b.x)]) == gen, bar);
            __builtin_amdgcn_fence(__ATOMIC_ACQUIRE, "agent");
            asm volatile("s_waitcnt vmcnt(0)" ::: "memory");
        }
    }
    __syncthreads();
}

__device__ __forceinline__ void wait_counter_ge(unsigned* word, unsigned want) {
    if (threadIdx.x < 64) {
        unsigned sp = 0u;
        while ((unsigned)__builtin_amdgcn_readfirstlane(__hip_atomic_load(word, __ATOMIC_RELAXED, __HIP_MEMORY_SCOPE_AGENT)) < want) { __builtin_amdgcn_s_sleep(2); if (++sp > (1u << 21)) break; }
        __builtin_amdgcn_fence(__ATOMIC_ACQUIRE, "agent");
        asm volatile("s_waitcnt vmcnt(0)" ::: "memory");
    }
    __syncthreads();
}

#define LDS_WAIT() asm volatile("s_waitcnt lgkmcnt(0)" ::: "memory")
__device__ __forceinline__ float wave_sum(float v) {
#pragma unroll
    for (int o = 1; o < 64; o <<= 1) v += __shfl_xor(v, o);
    return v;
}
__device__ __forceinline__ float silu_f(float x) { return x / (1.f + __expf(-x)); }

__device__ __forceinline__ void gemv_partials(const float* cvec, const float* wada, float* part, int G, int wave, int lane) {
    const int task = wave * G + (int)blockIdx.x;
    if (task >= 72 * 16) return;
    const int cgp = task % 72, ks = task / 72, k0 = ks * 128;
    const float sc0 = silu_f(cvec[k0 + lane]), sc1 = silu_f(cvec[k0 + 64 + lane]);
    const float* wp = wada + (size_t)k0 * NMOD + cgp * 256 + lane * 4;
    f32x4 a0 = {0.f, 0.f, 0.f, 0.f}, a1 = a0;
#pragma unroll 16
    for (int kk = 0; kk < 64; ++kk) { const f32x4 w = __builtin_nontemporal_load((const f32x4*)(wp + (size_t)kk * NMOD)); a0 += w * __shfl(sc0, kk); }
#pragma unroll 16
    for (int kk = 0; kk < 64; ++kk) { const f32x4 w = __builtin_nontemporal_load((const f32x4*)(wp + (size_t)(64 + kk) * NMOD)); a1 += w * __shfl(sc1, kk); }
    *(f32x4*)(part + (size_t)ks * NMOD + cgp * 256 + lane * 4) = a0 + a1;
}
__device__ __forceinline__ void mod_reduce(const float* part, const float* bada, float* mod) {
    const int col = (int)blockIdx.x * 512 + (int)threadIdx.x;
    if (col >= NMOD) return;
    float s = bada[col];
#pragma unroll
    for (int ks = 0; ks < 16; ++ks) s += part[(size_t)ks * NMOD + col];
    mod[col] = s;
}
__device__ __forceinline__ f32x4 mod_vec4(const float* part, const float* bada, int mi, int col) {
    f32x4 s = *(const f32x4*)(bada + mi * D + col);
#pragma unroll
    for (int ks = 0; ks < 16; ++ks) s += *(const f32x4*)(part + (size_t)ks * NMOD + mi * D + col);
    return s;
}
struct CvItem { const float* W; bf16* WT; float* bpart; const LAS float* sh; int N, ldt, dst_row0, k0, n0; };
__device__ __forceinline__ void cv_load(const CvItem& c, f32x4 (&v)[8], int lane) {
    const int kk = lane >> 3, q = lane & 7;
#pragma unroll
    for (int i = 0; i < 8; ++i) v[i] = __builtin_nontemporal_load((const f32x4*)(c.W + (size_t)(c.k0 + 8 * i + kk) * c.N + c.n0 + 4 * q));
}
__device__ __forceinline__ void cv_finish(const CvItem& c, const f32x4 (&v)[8], LAS float* scr, int lane) {
    const int kk = lane >> 3, q = lane & 7;
#pragma unroll
    for (int i = 0; i < 8; ++i) { LAS float* s = scr + (8 * i + kk) * 33 + 4 * q; s[0] = v[i][0]; s[1] = v[i][1]; s[2] = v[i][2]; s[3] = v[i][3]; }
    if (c.bpart != nullptr) {
        f32x4 bs = {0.f, 0.f, 0.f, 0.f};
#pragma unroll
        for (int i = 0; i < 8; ++i) { const float shv = c.sh[c.k0 + 8 * i + kk];
#pragma unroll
            for (int j = 0; j < 4; ++j) bs[j] += v[i][j] * shv; }
#pragma unroll
        for (int j = 0; j < 4; ++j) { bs[j] += __shfl_xor(bs[j], 8); bs[j] += __shfl_xor(bs[j], 16); bs[j] += __shfl_xor(bs[j], 32); }
        if (kk == 0) *(f32x4*)(c.bpart + c.dst_row0 + 4 * q) = bs;
    }
    LDS_WAIT(); asm volatile("" ::: "memory");
    const int cc = lane & 7;
#pragma unroll
    for (int j = 0; j < 4; ++j) { const int n = (lane >> 3) + 8 * j; const LAS float* s = scr + (8 * cc) * 33 + n;
        u32x4 o; o.x = pk2(s[0 * 33], s[1 * 33]); o.y = pk2(s[2 * 33], s[3 * 33]); o.z = pk2(s[4 * 33], s[5 * 33]); o.w = pk2(s[6 * 33], s[7 * 33]);
        *(u32x4*)(c.WT + (size_t)(c.dst_row0 + n) * c.ldt + c.k0 + 8 * cc) = o; }
    LDS_WAIT(); asm volatile("" ::: "memory");
}
__device__ __forceinline__ int in_row(int n0) { if (n0 < 2304) return n0; const int o = n0 - 2304, g = o >= D ? 1 : 0, jj = o - g * D; return 2304 + (jj >> 7) * 256 + g * 128 + (jj & 127); }
__device__ __forceinline__ int gu_row(int n0) { const int half = n0 >= FF ? 1 : 0, jj = n0 - half * FF; return (jj >> 7) * 256 + half * 128 + (jj & 127); }

struct Ptrs {
    const float *x, *c, *w_ada, *b_ada, *g_ffn1, *w_gu1, *w_d1, *g_mix, *w_in, *pool_mix, *pool_scale, *w_pu, *q_gain, *k_gain, *sinks, *rel_bias, *w_au, *w_o, *g_ffn2, *w_gu2, *w_d2;
    float* out; unsigned char* ws;
};

__device__ __forceinline__ CvItem cv_desc(const Ptrs& P, int r, const LAS float* sh3, const LAS float* sh6) {
    unsigned char* ws = P.ws; CvItem c; c.bpart = nullptr; c.sh = sh3;
    constexpr int I_GU = (D / 64) * (2 * FF / 32), I_DN = (FF / 64) * (D / 32), I_IN = (D / 64) * (INW / 32), I_PM = 4 * (256 / 64) * (256 / 32), I_UP = (1024 / 64) * (D / 32);
    if (r < I_GU) { const int nblk = 2 * FF / 32, kb = r / nblk, nb = r % nblk;
        c.W = P.w_gu1; c.N = 2 * FF; c.WT = (bf16*)(ws + WS_WGU1); c.ldt = LDP; c.dst_row0 = gu_row(nb * 32); c.k0 = kb * 64; c.n0 = nb * 32; return c; }
    r -= I_GU;
    if (r < I_GU) { const int nblk = 2 * FF / 32, kb = r / nblk, nb = r % nblk;
        c.W = P.w_gu2; c.N = 2 * FF; c.WT = (bf16*)(ws + WS_WGU2); c.ldt = LDP; c.dst_row0 = gu_row(nb * 32); c.k0 = kb * 64; c.n0 = nb * 32; c.sh = sh6; c.bpart = (float*)(ws + WS_BPGU) + (size_t)kb * (2 * FF); return c; }
    r -= I_GU;
    if (r < 2 * I_DN) { const bool second = r >= I_DN; if (second) r -= I_DN; const int nblk = D / 32, kb = r / nblk, nb = r % nblk;
        c.W = second ? P.w_d2 : P.w_d1; c.N = D; c.WT = (bf16*)(ws + (second ? WS_WD2 : WS_WD1)); c.ldt = FF; c.dst_row0 = nb * 32; c.k0 = kb * 64; c.n0 = nb * 32; return c; }
    r -= 2 * I_DN;
    if (r < I_IN) { const int nblk = INW / 32, kb = r / nblk, nb = r % nblk;
        c.W = P.w_in; c.N = INW; c.WT = (bf16*)(ws + WS_WIN); c.ldt = LDP; c.dst_row0 = in_row(nb * 32); c.k0 = kb * 64; c.n0 = nb * 32; c.bpart = (float*)(ws + WS_BPIN) + (size_t)kb * INW; return c; }
    r -= I_IN;
    if (r < I_PM) { const int g = r / 32, rr = r % 32, kb = rr / 8, nb = rr % 8;
        c.W = P.pool_mix + (size_t)g * 65536; c.N = 256; c.WT = (bf16*)(ws + WS_WPM) + (size_t)g * 65536; c.ldt = 256; c.dst_row0 = nb * 32; c.k0 = kb * 64; c.n0 = nb * 32; return c; }
    r -= I_PM;
    if (r < 2 * I_UP) { const bool second = r >= I_UP; if (second) r -= I_UP; const int nblk = D / 32, kb = r / nblk, nb = r % nblk;
        c.W = second ? P.w_au : P.w_pu; c.N = D; c.WT = (bf16*)(ws + (second ? WS_WAU : WS_WPU)); c.ldt = 1024; c.dst_row0 = nb * 32; c.k0 = kb * 64; c.n0 = nb * 32; return c; }
    r -= 2 * I_UP;
    { const int nblk = D / 32, kb = r / nblk, nb = r % nblk;
        c.W = P.w_o; c.N = D; c.WT = (bf16*)(ws + WS_WO); c.ldt = LDP; c.dst_row0 = nb * 32; c.k0 = kb * 64; c.n0 = nb * 32; return c; }
}
constexpr int CV_I_GU1 = (D / 64) * (2 * FF / 32);
constexpr int CV_NITEMS = 2 * CV_I_GU1 + 2 * (FF / 64) * (D / 32) + (D / 64) * (INW / 32) + 4 * (256 / 64) * (256 / 32) + 2 * (1024 / 64) * (D / 32) + (D / 64) * (D / 32);
__device__ __forceinline__ void convert_weights(const Ptrs& P, LAS unsigned char* lds, int lo, int hi, int gw, int NGW, int wave, int lane, const LAS float* sh3, const LAS float* sh6) {
    LAS float* scr = (LAS float*)(lds + wave * 16384);
    f32x4 va[8], vb[8], vc[8];
    int it = lo + gw;
    if (it >= hi) return;
    CvItem ia = cv_desc(P, it, sh3, sh6), ib = ia, ic = ia;
    cv_load(ia, va, lane);
    bool hb = (it + NGW) < hi, hc = (it + 2 * NGW) < hi;
    if (hb) { ib = cv_desc(P, it + NGW, sh3, sh6); cv_load(ib, vb, lane); }
    if (hc) { ic = cv_desc(P, it + 2 * NGW, sh3, sh6); cv_load(ic, vc, lane); }
#pragma unroll 1
    for (;;) {
        cv_finish(ia, va, scr, lane);
        if (!hb) break;
        { const int n = it + 3 * NGW; const bool h = n < hi; if (h) { ia = cv_desc(P, n, sh3, sh6); cv_load(ia, va, lane); }
          cv_finish(ib, vb, scr, lane);
          if (!hc) break;
          const int n2 = it + 4 * NGW; const bool h2 = n2 < hi; if (h2) { ib = cv_desc(P, n2, sh3, sh6); cv_load(ib, vb, lane); }
          cv_finish(ic, vc, scr, lane);
          if (!h) break;
          const int n3 = it + 5 * NGW; const bool h3 = n3 < hi; if (h3) { ic = cv_desc(P, n3, sh3, sh6); cv_load(ic, vc, lane); }
          it = n; hb = h2; hc = h3; }
    }
}

__device__ __forceinline__ void normmod_phase(const float* src, const LAS float* ta, const LAS float* tb, bf16* dst, int gw, int NGW, int lane) {
    f32x4 av[8], bv[8];
#pragma unroll
    for (int j = 0; j < 8; ++j) { const int col = 4 * lane + 256 * j; av[j] = *(const LAS f32x4*)(ta + col); bv[j] = *(const LAS f32x4*)(tb + col); }
    for (int m = gw; m < S; m += 2 * NGW) {
        const int m2 = m + NGW;
        const f32x4* xr = (const f32x4*)(src + (size_t)m * D) + lane; const f32x4* xr2 = (const f32x4*)(src + (size_t)m2 * D) + lane;
        f32x4 v[8], v2[8]; float ss = 0.f, ss2 = 0.f;
#pragma unroll
        for (int j = 0; j < 8; ++j) { v[j] = __builtin_nontemporal_load(xr + 64 * j); v2[j] = __builtin_nontemporal_load(xr2 + 64 * j); }
#pragma unroll
        for (int j = 0; j < 8; ++j) { ss += (v[j][0] * v[j][0] + v[j][1] * v[j][1]) + (v[j][2] * v[j][2] + v[j][3] * v[j][3]); ss2 += (v2[j][0] * v2[j][0] + v2[j][1] * v2[j][1]) + (v2[j][2] * v2[j][2] + v2[j][3] * v2[j][3]); }
        const float rstd = 1.0f / sqrtf(wave_sum(ss) * (1.0f / D) + EPS), rstd2 = 1.0f / sqrtf(wave_sum(ss2) * (1.0f / D) + EPS);
        u32x2* o8 = (u32x2*)(dst + (size_t)m * LDP) + lane; u32x2* o82 = (u32x2*)(dst + (size_t)m2 * LDP) + lane;
#pragma unroll
        for (int j = 0; j < 8; ++j) { const f32x4 o = v[j] * rstd * av[j] + bv[j]; u32x2 w; w.x = pk2(o[0], o[1]); w.y = pk2(o[2], o[3]); o8[64 * j] = w;
            const f32x4 o2 = v2[j] * rstd2 * av[j] + bv[j]; u32x2 w2; w2.x = pk2(o2[0], o2[1]); w2.y = pk2(o2[2], o2[3]); o82[64 * j] = w2; }
    }
}
__device__ __forceinline__ void bias_reduce(const float* bpin, const float* bpgu, float* bwin, float* bwgu) {
    const int t = (int)blockIdx.x * 512 + (int)threadIdx.x;
    if (t < INW) { float s = 0.f;
#pragma unroll 8
        for (int kb = 0; kb < 32; ++kb) s += bpin[(size_t)kb * INW + t];
        bwin[t] = s; }
    else if (t < INW + 2 * FF) { const int n = t - INW; float s = 0.f;
#pragma unroll 8
        for (int kb = 0; kb < 32; ++kb) s += bpgu[(size_t)kb * (2 * FF) + n];
        bwgu[n] = s; }
}

__device__ __forceinline__ void pooled_tile(const float* U, bf16* pooled, int pm, int g) {
    const int tid = threadIdx.x, cq = tid & 63, rc = tid >> 6, r0 = pm * 256 + rc * 32, col = g * 256 + cq * 4, w = 2 << g;
    const float* up = U + col;
    f32x4 sum = {0.f, 0.f, 0.f, 0.f};
    for (int i = 1; i < w; ++i) { const int r = r0 - i; if (r >= 0) sum += *(const f32x4*)(up + (size_t)r * PW); }
    for (int r = r0; r < r0 + 32; ++r) {
        const f32x4 cur = *(const f32x4*)(up + (size_t)r * PW);
        sum += cur;
        const float inv = 1.0f / (float)((r + 1) < w ? (r + 1) : w);
        const f32x4 o = sum * inv - cur;
        u32x2 pw; pw.x = pk2(o[0], o[1]); pw.y = pk2(o[2], o[3]);
        *(u32x2*)(pooled + (size_t)r * PW + col) = pw;
        const int ro = r - w + 1; if (ro >= 0) sum -= *(const f32x4*)(up + (size_t)ro * PW);
    }
}

constexpr int AT_KS = 0, AT_KROW = 144, AT_VT = 256 * 144, AT_VROW = 528, AT_BT = AT_VT + 64 * 528;
__device__ __forceinline__ int t5_bucket(int n) {
    if (n < 16) return n;
    int b = 16;
    b += (n >= 19) + (n >= 21) + (n >= 24) + (n >= 27) + (n >= 31) + (n >= 35) + (n >= 40) + (n >= 46) + (n >= 52) + (n >= 59) + (n >= 67) + (n >= 77) + (n >= 87) + (n >= 99) + (n >= 113);
    return b;
}
__device__ __forceinline__ void attn_unit(int nb, int h, const bf16* Q, const bf16* Kb, const bf16* Vb, bf16* O, const float* q_gain, const float* k_gain, const float* sinks, const float* rel_bias, LAS unsigned char* lds) {
    const int tid = threadIdx.x, lane = tid & 63, w = __builtin_amdgcn_readfirstlane(tid >> 6), c = lane & 15, g = lane >> 4;
    const int kvh = h >> 3;
    {
        const int row = tid >> 1, half = tid & 1; const int kpos = (nb - 1) * 128 + row;
        u32x4 kr[4], vr[4];
        if (kpos >= 0) {
            const u32x4* kp = (const u32x4*)(Kb + (size_t)kpos * KVW + kvh * 64 + half * 32); const u32x4* vp = (const u32x4*)(Vb + (size_t)kpos * KVW + kvh * 64 + half * 32);
#pragma unroll
            for (int i = 0; i < 4; ++i) { kr[i] = kp[i]; vr[i] = vp[i]; }
        } else {
#pragma unroll
            for (int i = 0; i < 4; ++i) { kr[i] = (u32x4){0u, 0u, 0u, 0u}; vr[i] = (u32x4){0u, 0u, 0u, 0u}; }
        }
        float kf[32]; float ss = 0.f;
#pragma unroll
        for (int i = 0; i < 4; ++i)
#pragma unroll
            for (int e = 0; e < 4; ++e) { const unsigned wd = kr[i][e]; kf[8 * i + 2 * e] = bflo(wd); kf[8 * i + 2 * e + 1] = bfhi(wd); }
#pragma unroll
        for (int i = 0; i < 32; ++i) ss += kf[i] * kf[i];
        ss += __shfl_xor(ss, 1);
        const float rstd = 1.0f / sqrtf(ss * (1.0f / 64.0f) + EPS);
        LAS unsigned char* kdst = lds + AT_KS + row * AT_KROW + half * 64;
#pragma unroll
        for (int i = 0; i < 4; ++i) { u32x4 o;
#pragma unroll
            for (int e = 0; e < 4; ++e) { const int d = half * 32 + 8 * i + 2 * e; o[e] = pk2(kf[8 * i + 2 * e] * rstd * k_gain[d], kf[8 * i + 2 * e + 1] * rstd * k_gain[d + 1]); }
            *(LAS u32x4*)(kdst + 16 * i) = o; }
#pragma unroll
        for (int i = 0; i < 4; ++i)
#pragma unroll
            for (int e = 0; e < 4; ++e) { const int d = half * 32 + 8 * i + 2 * e; const unsigned wd = vr[i][e];
                *(LAS unsigned short*)(lds + AT_VT + d * AT_VROW + row * 2) = (unsigned short)(wd & 0xffffu);
                *(LAS unsigned short*)(lds + AT_VT + (d + 1) * AT_VROW + row * 2) = (unsigned short)(wd >> 16); }
        if (tid < 128) ((LAS float*)(lds + AT_BT))[tid] = rel_bias[t5_bucket(tid) * NH + h] * LOG2E;
    }
    const int qrow = nb * 128 + w * 16 + c;
    bf16x8 qf[2];
    {
        const u32x4 q0 = *(const u32x4*)(Q + (size_t)qrow * AW + h * 64 + 8 * g), q1 = *(const u32x4*)(Q + (size_t)qrow * AW + h * 64 + 32 + 8 * g);
        float f0[8], f1[8]; float ss = 0.f;
#pragma unroll
        for (int e = 0; e < 4; ++e) { f0[2 * e] = bflo(q0[e]); f0[2 * e + 1] = bfhi(q0[e]); f1[2 * e] = bflo(q1[e]); f1[2 * e + 1] = bfhi(q1[e]); }
#pragma unroll
        for (int e = 0; e < 8; ++e) ss += f0[e] * f0[e] + f1[e] * f1[e];
        ss += __shfl_xor(ss, 16); ss += __shfl_xor(ss, 32);
        const float rs = (1.0f / sqrtf(ss * (1.0f / 64.0f) + EPS)) * (0.125f * LOG2E);
        u32x4 p0, p1;
#pragma unroll
        for (int e = 0; e < 4; ++e) { const int d = 8 * g + 2 * e; p0[e] = pk2(f0[2 * e] * rs * q_gain[d], f0[2 * e + 1] * rs * q_gain[d + 1]); p1[e] = pk2(f1[2 * e] * rs * q_gain[32 + d], f1[2 * e + 1] * rs * q_gain[32 + d + 1]); }
        qf[0] = __builtin_bit_cast(bf16x8, p0); qf[1] = __builtin_bit_cast(bf16x8, p1);
    }
    const float sink2 = sinks[h] * LOG2E;
    LDS_WAIT(); __syncthreads();
    f32x4 sv[9];
    const LAS float* bt = (const LAS float*)(lds + AT_BT);
    float mx = sink2;
#pragma unroll
    for (int kb = 0; kb < 9; ++kb) {
        const int krow = 16 * (w + kb) + c;
        const bf16x8 k0 = *(const LAS bf16x8*)(lds + AT_KS + krow * AT_KROW + 16 * g), k1 = *(const LAS bf16x8*)(lds + AT_KS + krow * AT_KROW + 64 + 16 * g);
        f32x4 a = {0.f, 0.f, 0.f, 0.f};
        a = __builtin_amdgcn_mfma_f32_16x16x32_bf16(k0, qf[0], a, 0, 0, 0);
        a = __builtin_amdgcn_mfma_f32_16x16x32_bf16(k1, qf[1], a, 0, 0, 0);
#pragma unroll
        for (int r = 0; r < 4; ++r) {
            const int dist = 128 + c - 16 * kb - 4 * g - r;
            const int j = 16 * (w + kb) + 4 * g + r;
            const bool ok = (dist >= 0) && (dist < 128) && (nb > 0 || j >= 128);
            const float lg = a[r] + bt[dist & 127];
            a[r] = ok ? lg : -1e30f;
            mx = fmaxf(mx, a[r]);
        }
        sv[kb] = a;
    }
    mx = fmaxf(mx, __shfl_xor(mx, 16)); mx = fmaxf(mx, __shfl_xor(mx, 32));
    float lsum = 0.f;
#pragma unroll
    for (int kb = 0; kb < 9; ++kb)
#pragma unroll
        for (int r = 0; r < 4; ++r) { const float p = __builtin_amdgcn_exp2f(sv[kb][r] - mx); sv[kb][r] = p; lsum += p; }
    lsum += __shfl_xor(lsum, 16); lsum += __shfl_xor(lsum, 32);
    lsum += __builtin_amdgcn_exp2f(sink2 - mx);
    const float inv = 1.0f / lsum;
    f32x4 oacc[4];
#pragma unroll
    for (int db = 0; db < 4; ++db) oacc[db] = (f32x4){0.f, 0.f, 0.f, 0.f};
#pragma unroll
    for (int ks = 0; ks < 5; ++ks) {
        u32x4 pw; pw.x = pk2(sv[2 * ks][0], sv[2 * ks][1]); pw.y = pk2(sv[2 * ks][2], sv[2 * ks][3]);
        if (ks < 4) { pw.z = pk2(sv[2 * ks + 1][0], sv[2 * ks + 1][1]); pw.w = pk2(sv[2 * ks + 1][2], sv[2 * ks + 1][3]); } else { pw.z = 0u; pw.w = 0u; }
        const bf16x8 pf = __builtin_bit_cast(bf16x8, pw);
        const int kb0 = w + 2 * ks, kb1r = w + 2 * ks + 1, kb1 = kb1r > 15 ? 15 : kb1r;
#pragma unroll
        for (int db = 0; db < 4; ++db) {
            const LAS unsigned char* vrow = lds + AT_VT + (16 * db + c) * AT_VROW;
            const u32x2 lo = *(const LAS u32x2*)(vrow + (16 * kb0 + 4 * g) * 2), hi = *(const LAS u32x2*)(vrow + (16 * kb1 + 4 * g) * 2);
            const u32x4 vw = {lo.x, lo.y, hi.x, hi.y};
            oacc[db] = __builtin_amdgcn_mfma_f32_16x16x32_bf16(__builtin_bit_cast(bf16x8, vw), pf, oacc[db], 0, 0, 0);
        }
    }
#pragma unroll
    for (int db = 0; db < 4; ++db) { u32x2 ow; ow.x = pk2(oacc[db][0] * inv, oacc[db][1] * inv); ow.y = pk2(oacc[db][2] * inv, oacc[db][3] * inv);
        *(u32x2*)(O + (size_t)qrow * AW + h * 64 + 16 * db + 4 * g) = ow; }
    LDS_WAIT(); __syncthreads();
}

struct Args { const float* in[21]; float* out; unsigned char* ws; };
__global__ void __launch_bounds__(512, 2) mega_fwd(Args args) {
    extern __shared__ __attribute__((aligned(16))) unsigned char lds_raw[];
    LAS unsigned char* lds = (LAS unsigned char*)lds_raw;
    const int tid = threadIdx.x, lane = tid & 63, wave = __builtin_amdgcn_readfirstlane(tid >> 6);
    const int G = gridDim.x, bx = blockIdx.x;
    const int vcu = (G % 8 == 0) ? (bx % 8) * (G / 8) + bx / 8 : bx;
    const int gw = vcu * 8 + wave, NGW = G * 8;
    Ptrs P;
    P.x = args.in[0]; P.c = args.in[1]; P.w_ada = args.in[2]; P.b_ada = args.in[3]; P.g_ffn1 = args.in[4]; P.w_gu1 = args.in[5]; P.w_d1 = args.in[6]; P.g_mix = args.in[7];
    P.w_in = args.in[8]; P.pool_mix = args.in[9]; P.pool_scale = args.in[10]; P.w_pu = args.in[11]; P.q_gain = args.in[12]; P.k_gain = args.in[13]; P.sinks = args.in[14];
    P.rel_bias = args.in[15]; P.w_au = args.in[16]; P.w_o = args.in[17]; P.g_ffn2 = args.in[18]; P.w_gu2 = args.in[19]; P.w_d2 = args.in[20]; P.out = args.out; P.ws = args.ws;
    unsigned char* ws = args.ws;
    unsigned* ctl = (unsigned*)(ws + WS_CTL);
    float* modp = (float*)(ws + WS_MODP); float* mod = (float*)(ws + WS_MOD); float* bwin = (float*)(ws + WS_BWIN); float* bwgu = (float*)(ws + WS_BWGU); float* rowp = (float*)(ws + WS_ROWP);
    bf16* Hb = (bf16*)(ws + WS_H); bf16* ACT = (bf16*)(ws + WS_ACT);
    float* Ub = (float*)(ws + WS_U); bf16* Qb = (bf16*)(ws + WS_Q); bf16* Kb = (bf16*)(ws + WS_K); bf16* Vb = (bf16*)(ws + WS_V);
    bf16* GA = (bf16*)(ws + WS_GA); bf16* GB = (bf16*)(ws + WS_GB); bf16* POOLED = (bf16*)(ws + WS_POOLED); bf16* MIXED = (bf16*)(ws + WS_MIXED); bf16* ATT = (bf16*)(ws + WS_ATT); bf16* MERGED = (bf16*)(ws + WS_MERGED); bf16* HX = (bf16*)(ws + WS_HX);

    volatile LAS unsigned* MISC = (volatile LAS unsigned*)(lds + MISC_OFF);
    if (tid < 64) ((LAS unsigned*)(lds + RING_BYTES))[tid + 64] = 0u;
    __syncthreads();
    XcdBarrier bar = xcd_barrier_post(ctl + CW_BAR, MISC + 8);
#define GRID_BAR() xcd_barrier(bar)

    if ((PHASE_MASK >> 0) & 1) gemv_partials(P.c, P.w_ada, modp, G, wave, lane);
    GRID_BAR();
    if ((PHASE_MASK >> 1) & 1) {
        mod_reduce(modp, P.b_ada, mod);
        LAS float* ta = (LAS float*)lds; LAS float* tb = ta + D;
        { const int col = 4 * tid; const f32x4 shv = mod_vec4(modp, P.b_ada, 0, col), scv = mod_vec4(modp, P.b_ada, 1, col), g = *(const f32x4*)(P.g_ffn1 + col);
          *(LAS f32x4*)(ta + col) = g * (scv + 1.0f); *(LAS f32x4*)(tb + col) = shv;
 }
        LDS_WAIT(); __syncthreads();
        normmod_phase(P.x, ta, tb, Hb, gw, NGW, lane);
        LDS_WAIT(); __syncthreads();
        convert_weights(P, lds, 0, CV_I_GU1, gw, NGW, wave, lane, nullptr, nullptr);
    }
    GRID_BAR();
    if ((PHASE_MASK >> 2) & 1) {
        const int kslot = ((bx >> 3) * 6) >> 5;
        LAS float* sh3 = (LAS float*)(lds + TAB_OFF); LAS float* sh6 = sh3 + D;
        *(LAS f32x4*)(sh3 + 4 * tid) = *(const f32x4*)(mod + 3 * D + 4 * tid); *(LAS f32x4*)(sh6 + 4 * tid) = *(const f32x4*)(mod + 6 * D + 4 * tid);
        LDS_WAIT(); __syncthreads();
        pg8::EpiSwiglu<false> E{ACT, FF, nullptr, nullptr};
        if (kslot > 0) { pg8::Sched Sc; Sc.init(S, 2 * FF, G, bx, Hb, ws + WS_WGU1, LDP, LDP); Sc.mode = 1; Sc.split_round = 5; Sc.split_mod = 128; Sc.r_hi = kslot;
            pg8::gemm_phase<pg8::EpiSwiglu<false>, true, true>(lds, D, LDP, LDP, Sc, E, ctl + CW_PANEL); }
        convert_weights(P, lds, CV_I_GU1, CV_NITEMS, gw, NGW, wave, lane, sh3, sh6);
        asm volatile("s_waitcnt vmcnt(0)" ::: "memory"); __syncthreads();
        if (tid == 0) { __builtin_amdgcn_fence(__ATOMIC_RELEASE, "agent"); asm volatile("s_waitcnt vmcnt(0)" ::: "memory");
            __hip_atomic_fetch_add(ctl + CW_CVDONE, 1u, __ATOMIC_RELAXED, __HIP_MEMORY_SCOPE_AGENT); }
        { pg8::Sched Sc; Sc.init(S, 2 * FF, G, bx, Hb, ws + WS_WGU1, LDP, LDP); Sc.mode = 1; Sc.split_round = 5; Sc.split_mod = 128; Sc.r_lo = kslot;
            pg8::gemm_phase<pg8::EpiSwiglu<false>, true, true>(lds, D, LDP, LDP, Sc, E, ctl + CW_PANEL); }
    }
    if ((PHASE_MASK >> 3) & 1) {
        pg8::Sched Sc; Sc.init(S, D, G, bx, ACT, ws + WS_WD1, FF, FF); Sc.mode = 2; pg8::EpiResid<true, true> E{P.x, P.out, mod + 2 * D, P.g_mix, mod + 4 * D, HX, rowp};
        wait_counter_ge(ctl + CW_CVDONE, (unsigned)G);
        bias_reduce((const float*)(ws + WS_BPIN), (const float*)(ws + WS_BPGU), bwin, bwgu);
        { pg8::Unit u0; (void)Sc.next(0, u0); wait_counter_ge(ctl + CW_PANEL + 64 * u0.pm, 44u * 8u * 2u); }
        pg8::gemm_phase<pg8::EpiResid<true, true>, false>(lds, FF, FF, FF, Sc, E);
    }
    GRID_BAR();
    if ((PHASE_MASK >> 4) & 1) {
        pg8::Sched Sc; Sc.init(S, INW, G, bx, HX, ws + WS_WIN, LDP, LDP); Sc.r_hi = 3; pg8::EpiIn E{Ub, Qb, Kb, Vb, GA, GB, rowp, bwin};
        pg8::gemm_phase<pg8::EpiIn, true>(lds, D, LDP, LDP, Sc, E);
    }
    GRID_BAR();
    if ((PHASE_MASK >> 5) & 1) {
        if (bx < 64) {
            pg8::Sched Sc; Sc.init(S, INW, G, bx, HX, ws + WS_WIN, LDP, LDP); Sc.r_lo = 3; Sc.split_round = 3; Sc.split_mod = 32; pg8::EpiIn E{Ub, Qb, Kb, Vb, GA, GB, rowp, bwin};
            pg8::gemm_phase<pg8::EpiIn, true>(lds, D, LDP, LDP, Sc, E);
        } else if (bx < 192) {
            pg8::Sched Sc; Sc.init(S, PW, 128, bx - 64, POOLED, ws + WS_WPM, PW, 256, 256 * 2);
            pg8::Unit u0; (void)Sc.next(0, u0);
            pooled_tile(Ub, POOLED, u0.pm, u0.pn);
            asm volatile("s_waitcnt vmcnt(0)" ::: "memory"); __syncthreads();
            if (tid == 0) { __builtin_amdgcn_fence(__ATOMIC_ACQUIRE, "agent"); asm volatile("s_waitcnt vmcnt(0)" ::: "memory"); }
            __syncthreads();
            pg8::EpiPoolMix E{MIXED, P.pool_scale};
            pg8::gemm_phase<pg8::EpiPoolMix, false>(lds, 256, PW, 256, Sc, E);
        }
        for (;;) {
            if (tid == 0) MISC[0] = __hip_atomic_fetch_add(ctl + CW_QHEAD, 1u, __ATOMIC_RELAXED, __HIP_MEMORY_SCOPE_AGENT);
            __syncthreads();
            const int uid = (int)MISC[0];
            __syncthreads();
            if (uid >= 1024) break;
            const int hh = uid & 7, grp = uid >> 3, kvh = grp & 1, nb = grp >> 1;
            attn_unit(nb, kvh * 8 + hh, Qb, Kb, Vb, ATT, P.q_gain, P.k_gain, P.sinks, P.rel_bias, lds);
        }
    }
    GRID_BAR();
    if ((PHASE_MASK >> 6) & 1) {
        pg8::Sched Sc; Sc.init(S, D, G, bx, MIXED, ws + WS_WPU, PW, PW, 0, ATT, ws + WS_WAU); pg8::EpiMerge E{GA, GB, MERGED};
        pg8::gemm_phase<pg8::EpiMerge, false>(lds, PW, PW, PW, Sc, E);
    }
    GRID_BAR();
    if ((PHASE_MASK >> 7) & 1) {
        pg8::Sched Sc; Sc.init(S, D, G, bx, MERGED, ws + WS_WO, LDP, LDP); pg8::EpiResid<true, false> E{P.out, P.out, mod + 5 * D, P.g_ffn2, mod + 7 * D, Hb, rowp};
        pg8::gemm_phase<pg8::EpiResid<true, false>, false>(lds, D, LDP, LDP, Sc, E);
    }
    GRID_BAR();
    if ((PHASE_MASK >> 8) & 1) {
        pg8::Sched Sc; Sc.init(S, 2 * FF, G, bx, Hb, ws + WS_WGU2, LDP, LDP); Sc.mode = 1; Sc.split_round = 5; Sc.split_mod = 128; pg8::EpiSwiglu<true> E{ACT, FF, rowp, bwgu};
        pg8::gemm_phase<pg8::EpiSwiglu<true>, true, true>(lds, D, LDP, LDP, Sc, E, ctl + CW_PANEL + 32 * 64);
    }
    if ((PHASE_MASK >> 9) & 1) {
        pg8::Sched Sc; Sc.init(S, D, G, bx, ACT, ws + WS_WD2, FF, FF); Sc.mode = 2; pg8::EpiResid<false, true> E{P.out, P.out, mod + 8 * D, nullptr, nullptr, nullptr, nullptr};
        { pg8::Unit u0; (void)Sc.next(0, u0); wait_counter_ge(ctl + CW_PANEL + 32 * 64 + 64 * u0.pm, 44u * 8u * 2u); }
        pg8::gemm_phase<pg8::EpiResid<false, true>, false>(lds, FF, FF, FF, Sc, E);
    }
#undef GRID_BAR
}

extern "C" void kernel_launch(void* const* d_in, const int* in_sizes, int n_in, void* d_out, int out_size, void* d_ws, size_t ws_size, hipStream_t stream) {
    static int grid = 0;
    if (grid == 0) {
        if (n_in != 21 || in_sizes[0] != S * D || out_size != S * D || ws_size < WS_END) { fprintf(stderr, "kernel_launch: unexpected shapes (n_in %d, in0 %d, out %d, ws %zu < %zu)\n", n_in, n_in > 0 ? in_sizes[0] : -1, out_size, ws_size, (size_t)WS_END); grid = -1; return; }
        int dev = 0, cus = 0, per_cu = 0;
        if (hipGetDevice(&dev) != hipSuccess || hipDeviceGetAttribute(&cus, hipDeviceAttributeMultiprocessorCount, dev) != hipSuccess) { grid = -1; return; }
        if (hipFuncSetAttribute((const void*)mega_fwd, hipFuncAttributeMaxDynamicSharedMemorySize, LDS_BYTES) != hipSuccess) { fprintf(stderr, "kernel_launch: hipFuncSetAttribute failed\n"); grid = -1; return; }
        if (hipOccupancyMaxActiveBlocksPerMultiprocessor(&per_cu, (const void*)mega_fwd, 512, LDS_BYTES) != hipSuccess || per_cu < 1) { fprintf(stderr, "kernel_launch: occupancy query says %d blocks per CU\n", per_cu); grid = -1; return; }
        (void)hipGetLastError();
        grid = cus;
        if (grid != 256) { fprintf(stderr, "kernel_launch: built for a 256-CU device, found %d CUs\n", cus); grid = -1; return; }
    }
    if (grid < 0) return;
    (void)hipMemsetAsync((char*)d_ws + WS_CTL, 0, CTL_ZERO_BYTES, stream);
    Args a{};
    for (int i = 0; i < 21; ++i) a.in[i] = (const float*)d_in[i];
    a.out = (float*)d_out; a.ws = (unsigned char*)d_ws;
    void* kargs[] = {&a};
    hipError_t e = hipLaunchCooperativeKernel((const void*)mega_fwd, dim3(grid), dim3(512), kargs, LDS_BYTES, stream);
    if (e != hipSuccess) fprintf(stderr, "kernel_launch: cooperative launch failed: %s (grid %d)\n", hipGetErrorString(e), grid);
}
```

```cpp
#include <hip/hip_runtime.h>
#include <cstdio>
#include <cstdint>


#ifndef PHASE_MASK
#define PHASE_MASK 0xFFFF
#endif
#define LAS __attribute__((address_space(3)))
typedef unsigned short bf16;
typedef short bf16x8 __attribute__((ext_vector_type(8)));
typedef short s16x4 __attribute__((ext_vector_type(4)));
typedef float f32x4 __attribute__((ext_vector_type(4)));
typedef float f32x2 __attribute__((ext_vector_type(2)));
typedef unsigned u32x4 __attribute__((ext_vector_type(4)));
typedef unsigned u32x2 __attribute__((ext_vector_type(2)));
typedef __bf16 bf16x2_t __attribute__((ext_vector_type(2)));

__device__ __forceinline__ unsigned pk2(float lo, float hi) { f32x2 v = {lo, hi}; bf16x2_t b = __builtin_convertvector(v, bf16x2_t); return __builtin_bit_cast(unsigned, b); }
__device__ __forceinline__ float bflo(unsigned w) { return __uint_as_float(w << 16); }
__device__ __forceinline__ float bfhi(unsigned w) { return __uint_as_float(w & 0xffff0000u); }
__device__ __forceinline__ float sigmoid_f(float x) { return __builtin_amdgcn_rcpf(1.f + __builtin_amdgcn_exp2f(-1.4426950408889634f * x)); }

constexpr int S = 8192, D = 2048, FF = 5632, INW = 6400, PW = 1024, AW = 1024, KVW = 128, NH = 16, HD = 64;
constexpr int NMOD = 9 * D;
constexpr float EPS = 1e-6f;
constexpr float LOG2E = 1.4426950408889634f;

constexpr size_t MiB = 1u << 20;
constexpr size_t WS_CTL = 0, CTL_ZERO_BYTES = 64 * 1024;
constexpr size_t WS_MODP = 1 * MiB;
constexpr size_t WS_MOD = 2 * MiB + 512 * 1024;
constexpr size_t WS_BWIN = WS_MOD + 128 * 1024, WS_BWGU = WS_MOD + 192 * 1024;
constexpr size_t WS_ROWP = 3 * MiB;
constexpr size_t WS_BPIN = 4 * MiB;
constexpr size_t WS_BPGU = 5 * MiB;
constexpr size_t WS_WGU1 = 8 * MiB;
constexpr size_t WS_WD1 = WS_WGU1 + 44 * MiB;
constexpr size_t WS_WIN = WS_WD1 + 22 * MiB;
constexpr size_t WS_WPM = WS_WIN + 25 * MiB;
constexpr size_t WS_WPU = WS_WPM + 1 * MiB;
constexpr size_t WS_WAU = WS_WPU + 4 * MiB;
constexpr size_t WS_WO = WS_WAU + 4 * MiB;
constexpr size_t WS_WGU2 = WS_WO + 8 * MiB;
constexpr size_t WS_WD2 = WS_WGU2 + 44 * MiB;
constexpr size_t WS_H = WS_WD2 + 22 * MiB;
constexpr size_t WS_BIG = WS_H + 32 * MiB;
constexpr size_t WS_ACT = WS_BIG;
constexpr size_t WS_U = WS_BIG;
constexpr size_t WS_Q = WS_U + 32 * MiB;
constexpr size_t WS_K = WS_Q + 16 * MiB;
constexpr size_t WS_V = WS_K + 2 * MiB;
constexpr size_t WS_GA = WS_V + 2 * MiB;
constexpr size_t WS_GB = WS_GA + 32 * MiB;
constexpr size_t WS_POOLED = WS_GB + 32 * MiB;
constexpr size_t WS_MIXED = WS_POOLED + 16 * MiB;
constexpr size_t WS_ATT = WS_MIXED + 16 * MiB;
constexpr size_t WS_MERGED = WS_ATT + 16 * MiB;
constexpr size_t WS_HX = WS_MERGED + 32 * MiB;
constexpr size_t WS_END = WS_HX + 32 * MiB;
static_assert(WS_ACT + (size_t)S * FF * 2 <= WS_END, "act fits in the big region");
constexpr int CW_BAR = 1024, CW_QHEAD = 8192, CW_CVDONE = 8256, CW_PANEL = 12288;

namespace pg8 {
constexpr int BM = 256, BK = 64, HALF = 128, HTB = HALF * BK * 2, STAGE_BYTES = 8 * HTB, NXCD = 8, WGM = 8;
__device__ __forceinline__ int lds_byte(int r, int c) { const int st = (r >> 4) * 2 + (c >> 5), rr = r & 15, cc = c & 31, ob = rr * 64 + cc * 2; return st * 1024 + (ob ^ (((ob >> 9) & 1) << 5)); }
__device__ __forceinline__ void stage_rc(int b, int& R, int& C) { const int st = b / 1024, sb = b % 1024, swz = sb ^ (((sb >> 9) & 1) << 5); R = (st >> 1) * 16 + swz / 64; C = (st & 1) * 32 + (swz % 64) / 2; }
__device__ __forceinline__ int perm32(int rho) { const int n = rho >> 4, i = rho & 15; return 8 * (i >> 2) + 4 * n + (i & 3); }

struct Unit { int pm, pn, kind, rowbase, halfm; const char* A; const char* B; };

struct Sched {
    int split_round, split_mod;
    int nM, nN, nwg, G, c, dual, r_lo, r_hi, mode;
    const char *A0, *B0, *A1, *B1; size_t a_tile, b_tile, a_pn;
    __device__ __forceinline__ void init(int M, int N, int G_, int c_, const void* A0_, const void* B0_, size_t lda, size_t ldb, size_t a_pn_bytes = 0, const void* A1_ = nullptr, const void* B1_ = nullptr) {
        nM = M / BM; nN = N / BM; nwg = nM * nN; G = G_; c = c_; dual = (A1_ != nullptr); r_lo = 0; r_hi = 1 << 30; mode = 0; split_round = 1 << 30; split_mod = 1;
        A0 = (const char*)A0_; B0 = (const char*)B0_; A1 = (const char*)A1_; B1 = (const char*)B1_;
        a_tile = (size_t)BM * lda * 2; b_tile = (size_t)BM * ldb * 2; a_pn = a_pn_bytes;
    }
    __device__ __forceinline__ bool next(int i, Unit& u) const {
        const int ti = (dual ? (i >> 1) : i) + r_lo; if (ti >= r_hi || ti > split_round) return false;
        const bool hs = (ti == split_round);
        const long L = (long)ti * G + (hs ? c % split_mod : c); if (L >= nwg) return false;
        u.halfm = hs ? 1 : 0;
        if (mode == 2) {
            if (i > 0) return false;
            const int x = c & 7, j = c >> 3, early = j >= 16 ? 1 : 0, jj = j & 15;
            u.pm = 8 * (x >> 1) + (early ? 0 : 4) + 2 * (x & 1) + (jj >> 3); u.pn = jj & 7;
        } else {
        int wgid = (int)L; { const int q = nwg / NXCD, r = nwg % NXCD, xcd = wgid % NXCD, off = wgid / NXCD; wgid = (xcd < r ? xcd * (q + 1) : r * (q + 1) + (xcd - r) * q) + off; }
        const int nig = WGM * nN, gid = wgid / nig, fm = gid * WGM, gsz = (nM - fm) < WGM ? (nM - fm) : WGM;
        if (mode == 1) {
            const int idx = wgid % nig, hf = idx / 176, off = idx % 176, sec = off / 88, o2 = off % 88;
            u.pm = fm + 4 * sec + (o2 & 3); u.pn = 22 * hf + (o2 >> 2);
        } else { u.pm = fm + ((wgid % nig) % gsz); u.pn = (wgid % nig) / gsz; }
        }
        const int sub = dual ? (i & 1) : 0; u.kind = dual ? (1 + sub) : 0;
        u.rowbase = u.pm * BM + (hs ? (c / split_mod) * HALF : 0);
        u.A = (sub ? A1 : A0) + (size_t)u.pm * a_tile + (size_t)u.pn * a_pn + (hs ? (size_t)(c / split_mod) * (a_tile / 2) : 0);
        u.B = (sub ? B1 : B0) + (size_t)u.pn * b_tile;
        return true;
    }
};

template <class Epi, bool ALIGN_EPI, bool PUB = false>
__device__ __forceinline__ void gemm_phase(LAS unsigned char* lds, const int K, const int lda, const int ldb, const Sched& S, const Epi& E, unsigned* ctr = nullptr) {
    int tid_ = threadIdx.x; asm volatile("" : "+v"(tid_));
    const int tid = tid_, wid = __builtin_amdgcn_readfirstlane(tid >> 6), lane = tid & 63, wr = wid >> 2, wc = wid & 3, fr = lane & 15, fq = lane >> 4;
    const int nt = K / BK;
    unsigned voffA[2], voffB[2];
#pragma unroll
    for (int i = 0; i < 2; ++i) { int R, C; stage_rc(tid * 16 + i * 8192, R, C); const int Rb = (R & ~31) + perm32(R & 31);
        voffA[i] = (unsigned)(R * lda + C) * 2u; voffB[i] = (unsigned)(Rb * ldb + C) * 2u; }
    const size_t kstep = (size_t)(BK * 2);
    const size_t hstepA_full = (size_t)HALF * lda * 2, hstepB = (size_t)HALF * ldb * 2;
    const unsigned ldsw = (unsigned)wid * 1024u;
    const int aoff = lds_byte(wr * 64 + fr, fq * 8), boff = lds_byte(wc * 32 + fr, fq * 8);
#define PG8_SA(b, h) (((b) * 2 + (h)) * HTB)
#define PG8_SB(b, h) ((4 + (b) * 2 + (h)) * HTB)
#define PG8_STAGE(bufoff, gbase, voff) do { _Pragma("unroll") for (int _i = 0; _i < 2; ++_i) \
        __builtin_amdgcn_global_load_lds((const unsigned*)((const char*)(gbase) + (voff)[_i]), (LAS unsigned*)(lds + (bufoff) + ldsw + _i * 8192), 16, 0, 0); } while (0)
#define PG8_LDA(dst, b, h) do { _Pragma("unroll") for (int m = 0; m < 4; ++m) _Pragma("unroll") for (int k = 0; k < 2; ++k) dst[m][k] = *(const LAS bf16x8*)(lds + PG8_SA(b, h) + aoff + m * 2048 + k * 1024); } while (0)
#define PG8_LDB(dst, b, h) do { _Pragma("unroll") for (int n = 0; n < 2; ++n) _Pragma("unroll") for (int k = 0; k < 2; ++k) dst[n][k] = *(const LAS bf16x8*)(lds + PG8_SB(b, h) + boff + n * 2048 + k * 1024); } while (0)
#define PG8_MMA(ai, bj, At, Bt) do { __builtin_amdgcn_s_setprio(1); _Pragma("unroll") for (int m = 0; m < 4; ++m) _Pragma("unroll") for (int n = 0; n < 2; ++n) _Pragma("unroll") for (int k = 0; k < 2; ++k) \
        acc[ai][bj][m][n] = __builtin_amdgcn_mfma_f32_16x16x32_bf16(Bt[n][k], At[m][k], acc[ai][bj][m][n], 0, 0, 0); __builtin_amdgcn_s_setprio(0); } while (0)
#define PG8_WAIT_V(n) asm volatile("s_waitcnt vmcnt(" #n ")" ::: "memory")
#define PG8_WAIT_L(n) asm volatile("s_waitcnt lgkmcnt(" #n ")" ::: "memory")
#define PG8_BAR __builtin_amdgcn_s_barrier()
#define PG8_SCHED __builtin_amdgcn_sched_barrier(0)
    Unit cur, nxt; int ui = 0; int pend_pm = -1; unsigned pend_n = 0u;
    if (!S.next(0, cur)) return;
    f32x4 acc[2][2][4][2];
#pragma unroll
    for (int a = 0; a < 2; ++a)
#pragma unroll
        for (int b = 0; b < 2; ++b)
#pragma unroll
            for (int m = 0; m < 4; ++m)
#pragma unroll
                for (int n = 0; n < 2; ++n) acc[a][b][m][n] = (f32x4){0.f, 0.f, 0.f, 0.f};
    bf16x8 At[4][2], B0[2][2], B1[2][2];
    const char* cA = cur.A; const char* cB = cur.B;
    size_t hstepA = cur.halfm ? 0 : hstepA_full;
    PG8_STAGE(PG8_SB(0, 0), cB, voffB); PG8_STAGE(PG8_SB(0, 1), cB + hstepB, voffB); PG8_STAGE(PG8_SA(0, 0), cA, voffA); PG8_STAGE(PG8_SA(0, 1), cA + hstepA, voffA);
    if (wr == 1) PG8_BAR;
    PG8_WAIT_V(2); PG8_BAR;
    PG8_STAGE(PG8_SB(1, 0), cB + kstep, voffB); PG8_STAGE(PG8_SA(1, 0), cA + kstep, voffA); PG8_STAGE(PG8_SB(1, 1), cB + hstepB + kstep, voffB);
    PG8_WAIT_V(6); PG8_BAR;
    for (;;) {
        const bool has_next = S.next(ui + 1, nxt);
        const char* nA = has_next ? nxt.A : cA; const char* nB = has_next ? nxt.B : cB;
        const size_t hstepA_n = has_next ? (nxt.halfm ? 0 : hstepA_full) : hstepA; const bool fullm = !cur.halfm;
#pragma unroll 1
        for (int t = 0; t < nt; t += 2) {
            const bool last = (t == nt - 2);
            const char* a1 = cA + (size_t)(t + 1) * kstep;
            const char* a2 = last ? nA : cA + (size_t)(t + 2) * kstep; const char* b2 = last ? nB : cB + (size_t)(t + 2) * kstep;
            const char* a3 = a2 + kstep; const char* b3 = b2 + kstep;
            PG8_LDB(B0, 0, 0); PG8_LDB(B1, 0, 1); PG8_SCHED; PG8_LDA(At, 0, 0); PG8_STAGE(PG8_SA(1, 1), a1 + hstepA, voffA);
            PG8_WAIT_V(8); PG8_WAIT_L(0); PG8_BAR; PG8_MMA(0, 0, At, B0); PG8_MMA(0, 1, At, B1); PG8_BAR; PG8_SCHED;
            if (fullm) PG8_LDA(At, 0, 1); PG8_STAGE(PG8_SB(0, 0), b2, voffB); PG8_STAGE(PG8_SB(0, 1), b2 + hstepB, voffB); PG8_STAGE(PG8_SA(0, 0), a2, voffA);
            PG8_WAIT_V(8); PG8_WAIT_L(0); PG8_BAR; if (fullm) { PG8_MMA(1, 0, At, B0); PG8_MMA(1, 1, At, B1); } PG8_BAR; PG8_SCHED;
            PG8_LDB(B0, 1, 0); PG8_LDB(B1, 1, 1); PG8_SCHED; PG8_LDA(At, 1, 0); PG8_STAGE(PG8_SA(0, 1), a2 + (last ? hstepA_n : hstepA), voffA);
            PG8_WAIT_V(8); PG8_WAIT_L(0); PG8_BAR; PG8_MMA(0, 0, At, B0); PG8_MMA(0, 1, At, B1); PG8_BAR; PG8_SCHED;
            if (fullm) PG8_LDA(At, 1, 1); PG8_STAGE(PG8_SB(1, 0), b3, voffB); PG8_STAGE(PG8_SB(1, 1), b3 + hstepB, voffB); PG8_STAGE(PG8_SA(1, 0), a3, voffA);
            PG8_WAIT_V(8); PG8_WAIT_L(0); PG8_BAR; if (fullm) { PG8_MMA(1, 0, At, B0); PG8_MMA(1, 1, At, B1); } PG8_BAR; PG8_SCHED;
        }
        if constexpr (ALIGN_EPI) { if (wr == 0) PG8_BAR; }
        if constexpr (PUB) {
            if (pend_n != 0u && cur.pm != pend_pm) { PG8_WAIT_V(0); if (lane == 0) __hip_atomic_fetch_add(ctr + 64 * pend_pm, pend_n, __ATOMIC_RELAXED, __HIP_MEMORY_SCOPE_AGENT); pend_n = 0u; }
            pend_pm = cur.pm; pend_n += cur.halfm ? 1u : 2u; }
        const bool keep = E(acc, cur, wr, wc, fr, fq);
        if (!has_next) break;
        if (!keep) {
#pragma unroll
            for (int a = 0; a < 2; ++a)
#pragma unroll
                for (int b = 0; b < 2; ++b)
#pragma unroll
                    for (int m = 0; m < 4; ++m)
#pragma unroll
                        for (int n = 0; n < 2; ++n) acc[a][b][m][n] = (f32x4){0.f, 0.f, 0.f, 0.f};
        }
        cur = nxt; cA = nA; cB = nB; hstepA = hstepA_n; ++ui;
        if constexpr (ALIGN_EPI) { if (wr == 1) PG8_BAR; }
    }
    PG8_WAIT_V(0);
    if constexpr (PUB) { if (pend_n != 0u && lane == 0) __hip_atomic_fetch_add(ctr + 64 * pend_pm, pend_n, __ATOMIC_RELAXED, __HIP_MEMORY_SCOPE_AGENT); }
    if constexpr (!ALIGN_EPI) { if (wr == 0) PG8_BAR; }
    PG8_BAR;
#undef PG8_SA
#undef PG8_SB
#undef PG8_STAGE
#undef PG8_LDA
#undef PG8_LDB
#undef PG8_MMA
#undef PG8_WAIT_V
#undef PG8_WAIT_L
#undef PG8_BAR
#undef PG8_SCHED
}

typedef f32x4 (&AccRef)[2][2][4][2];
__device__ __forceinline__ u32x4 pack8(const f32x4 v0, const f32x4 v1) { u32x4 w; w.x = pk2(v0[0], v0[1]); w.y = pk2(v0[2], v0[3]); w.z = pk2(v1[0], v1[1]); w.w = pk2(v1[2], v1[3]); return w; }

__device__ __forceinline__ float row_rstd(const float* rowpart, int row) {
    const f32x4* p = (const f32x4*)(rowpart + (size_t)row * 32);
    f32x4 s4 = p[0];
#pragma unroll
    for (int i = 1; i < 8; ++i) s4 += p[i];
    return 1.0f / sqrtf(((s4[0] + s4[1]) + (s4[2] + s4[3])) * (1.0f / D) + EPS);
}
__device__ __forceinline__ void apply_rs_bias(AccRef acc, const float* rowpart, int rowbase, int fr, const float* bias, int bcol0, int halfm) {
    const int lane = threadIdx.x & 63;
    f32x4 bv[2][2];
#pragma unroll
    for (int bj = 0; bj < 2; ++bj)
#pragma unroll
        for (int n = 0; n < 2; ++n) bv[bj][n] = *(const f32x4*)(bias + bcol0 + bj * HALF + 4 * n);
    float rv[2];
    rv[0] = row_rstd(rowpart, rowbase + lane); rv[1] = halfm ? 1.0f : row_rstd(rowpart, rowbase + HALF + lane);
#pragma unroll
    for (int ai = 0; ai < 2; ++ai)
#pragma unroll
        for (int m = 0; m < 4; ++m) { const float rs = __shfl(rv[ai], m * 16 + fr);
#pragma unroll
            for (int bj = 0; bj < 2; ++bj)
#pragma unroll
                for (int n = 0; n < 2; ++n) acc[ai][bj][m][n] = acc[ai][bj][m][n] * rs + bv[bj][n]; }
}
template <bool NORM> struct EpiSwiglu {
    bf16* O; int ldc; const float* rowpart; const float* bias;
    __device__ __forceinline__ bool operator()(AccRef acc, const Unit& u, int wr, int wc, int fr, int fq) const {
        const int row0 = u.rowbase + wr * 64 + fr, col0 = u.pn * HALF + wc * 32 + 8 * fq;
        if constexpr (NORM) apply_rs_bias(acc, rowpart, u.rowbase + wr * 64, fr, bias, u.pn * BM + wc * 32 + 8 * fq, u.halfm);
        const __amdgpu_buffer_rsrc_t rs_o = __builtin_amdgcn_make_buffer_rsrc(O, 0, S * FF * 2, 0x00020000);
#pragma unroll
        for (int ai = 0; ai < 2; ++ai) if (!(ai == 1 && u.halfm))
#pragma unroll
            for (int m = 0; m < 4; ++m) {
                f32x4 o[2];
#pragma unroll
                for (int n = 0; n < 2; ++n) { const f32x4 g = acc[ai][0][m][n], up = acc[ai][1][m][n];
#pragma unroll
                    for (int j = 0; j < 4; ++j) o[n][j] = g[j] * up[j] * sigmoid_f(g[j]); }
                __builtin_amdgcn_raw_buffer_store_b128(pack8(o[0], o[1]), rs_o, (unsigned)(((row0 + ai * HALF + m * 16) * ldc + col0) * 2), 0,   16);
            }
        return false;
    }
};
template <bool NEXT, bool HALFG> struct EpiResid {
    static constexpr float gsc = HALFG ? 0.5f : 1.0f;
    const float* base; float* out; const float* gate; const float* gn; const float* scn; bf16* XA; float* rowpart;
    __device__ __forceinline__ bool operator()(AccRef acc, const Unit& u, int wr, int wc, int fr, int fq) const {
        const int row0 = u.rowbase + wr * 64 + fr, col0 = u.pn * BM + wc * 32 + 8 * fq;
        f32x4 gv[2][2], an[2][2];
#pragma unroll
        for (int bj = 0; bj < 2; ++bj)
#pragma unroll
            for (int n = 0; n < 2; ++n) { gv[bj][n] = *(const f32x4*)(gate + col0 + bj * HALF + 4 * n) * gsc;
                if constexpr (NEXT) an[bj][n] = *(const f32x4*)(gn + col0 + bj * HALF + 4 * n) * (*(const f32x4*)(scn + col0 + bj * HALF + 4 * n) + 1.0f); }
#pragma unroll
        for (int ai = 0; ai < 2; ++ai)
#pragma unroll
            for (int m = 0; m < 4; ++m) { const int row = row0 + ai * HALF + m * 16; const size_t off = (size_t)row * D + col0; float ss = 0.f;
#pragma unroll
                for (int bj = 0; bj < 2; ++bj) {
                    const f32x4 b0 = *(const f32x4*)(base + off + bj * HALF), b1 = *(const f32x4*)(base + off + bj * HALF + 4);
                    const f32x4 x0 = b0 + gv[bj][0] * acc[ai][bj][m][0], x1 = b1 + gv[bj][1] * acc[ai][bj][m][1];
                    *(f32x4*)(out + off + bj * HALF) = x0; *(f32x4*)(out + off + bj * HALF + 4) = x1;
                    if constexpr (NEXT) {
                        ss += ((x0[0] * x0[0] + x0[1] * x0[1]) + (x0[2] * x0[2] + x0[3] * x0[3])) + ((x1[0] * x1[0] + x1[1] * x1[1]) + (x1[2] * x1[2] + x1[3] * x1[3]));
                        *(u32x4*)(XA + off + bj * HALF) = pack8(x0 * an[bj][0], x1 * an[bj][1]); } }
                if constexpr (NEXT) { ss += __shfl_xor(ss, 16); ss += __shfl_xor(ss, 32); if (fq == 0) rowpart[(size_t)row * 32 + u.pn * 4 + wc] = ss; }
                if (m & 1) asm volatile("" ::: "memory"); }
        return false;
    }
};
struct EpiIn {
    float* U; bf16* Q; bf16* Kb; bf16* Vb; bf16* GA; bf16* GB; const float* rowpart; const float* bias;
    __device__ __forceinline__ bool operator()(AccRef acc, const Unit& u, int wr, int wc, int fr, int fq) const {
        const int row0 = u.rowbase + wr * 64 + fr, cw = wc * 32 + 8 * fq; const int pn = u.pn;
        apply_rs_bias(acc, rowpart, u.rowbase + wr * 64, fr, bias, pn * BM + cw, u.halfm);
        if (pn < 4) {
#pragma unroll
            for (int ai = 0; ai < 2; ++ai) if (!(ai == 1 && u.halfm))
#pragma unroll
                for (int m = 0; m < 4; ++m) { float* rp = U + (size_t)(row0 + ai * HALF + m * 16) * PW + pn * BM + cw;
#pragma unroll
                    for (int bj = 0; bj < 2; ++bj) { *(f32x4*)(rp + bj * HALF) = acc[ai][bj][m][0]; *(f32x4*)(rp + bj * HALF + 4) = acc[ai][bj][m][1]; } }
        } else if (pn < 8) {
#pragma unroll
            for (int ai = 0; ai < 2; ++ai) if (!(ai == 1 && u.halfm))
#pragma unroll
                for (int m = 0; m < 4; ++m) { bf16* rp = Q + (size_t)(row0 + ai * HALF + m * 16) * AW + (pn - 4) * BM + cw;
#pragma unroll
                    for (int bj = 0; bj < 2; ++bj) *(u32x4*)(rp + bj * HALF) = pack8(acc[ai][bj][m][0], acc[ai][bj][m][1]); }
        } else if (pn == 8) {
#pragma unroll
            for (int ai = 0; ai < 2; ++ai) if (!(ai == 1 && u.halfm))
#pragma unroll
                for (int m = 0; m < 4; ++m) { const size_t ro = (size_t)(row0 + ai * HALF + m * 16) * KVW + cw;
                    *(u32x4*)(Kb + ro) = pack8(acc[ai][0][m][0], acc[ai][0][m][1]); *(u32x4*)(Vb + ro) = pack8(acc[ai][1][m][0], acc[ai][1][m][1]); }
        } else {
            const int ct = (pn - 9) * HALF + cw;
#pragma unroll
            for (int ai = 0; ai < 2; ++ai) if (!(ai == 1 && u.halfm))
#pragma unroll
                for (int m = 0; m < 4; ++m) { const size_t ro = (size_t)(row0 + ai * HALF + m * 16) * D + ct; f32x4 r0, r1, s0, s1;
#pragma unroll
                    for (int j = 0; j < 4; ++j) {
                        const float ea0 = __builtin_amdgcn_exp2f(-LOG2E * acc[ai][0][m][0][j]), eb0 = __builtin_amdgcn_exp2f(-LOG2E * acc[ai][1][m][0][j]);
                        const float ea1 = __builtin_amdgcn_exp2f(-LOG2E * acc[ai][0][m][1][j]), eb1 = __builtin_amdgcn_exp2f(-LOG2E * acc[ai][1][m][1][j]);
                        s0[j] = fmaxf(__builtin_amdgcn_rcpf(1.f + eb0), 1e-30f); s1[j] = fmaxf(__builtin_amdgcn_rcpf(1.f + eb1), 1e-30f);
                        r0[j] = __builtin_amdgcn_rcpf(1.f + ea0) * __builtin_amdgcn_rcpf(s0[j]); r1[j] = __builtin_amdgcn_rcpf(1.f + ea1) * __builtin_amdgcn_rcpf(s1[j]); }
                    *(u32x4*)(GA + ro) = pack8(r0, r1); *(u32x4*)(GB + ro) = pack8(s0, s1); asm volatile("" ::: "memory"); }
        }
        return false;
    }
};
struct EpiPoolMix {
    bf16* O; const float* pscale;
    __device__ __forceinline__ bool operator()(AccRef acc, const Unit& u, int wr, int wc, int fr, int fq) const {
        const int row0 = u.rowbase + wr * 64 + fr, col0 = u.pn * BM + wc * 32 + 8 * fq;
        f32x4 sv[2][2];
#pragma unroll
        for (int bj = 0; bj < 2; ++bj)
#pragma unroll
            for (int n = 0; n < 2; ++n) sv[bj][n] = *(const f32x4*)(pscale + col0 + bj * HALF + 4 * n);
#pragma unroll
        for (int ai = 0; ai < 2; ++ai)
#pragma unroll
            for (int m = 0; m < 4; ++m) { bf16* rp = O + (size_t)(row0 + ai * HALF + m * 16) * PW + col0;
#pragma unroll
                for (int bj = 0; bj < 2; ++bj) *(u32x4*)(rp + bj * HALF) = pack8(acc[ai][bj][m][0] * sv[bj][0], acc[ai][bj][m][1] * sv[bj][1]); }
        return false;
    }
};
struct EpiMerge {
    const bf16* R; const bf16* SB; bf16* O;
    __device__ __forceinline__ bool operator()(AccRef acc, const Unit& u, int wr, int wc, int fr, int fq) const {
        const int row0 = u.rowbase + wr * 64 + fr, col0 = u.pn * BM + wc * 32 + 8 * fq;
        const bool first = (u.kind == 1);
        const bf16* G = first ? R : SB;
#pragma unroll
        for (int ai = 0; ai < 2; ++ai) if (!(ai == 1 && u.halfm)) {
            u32x4 w[4][2];
#pragma unroll
            for (int m = 0; m < 4; ++m)
#pragma unroll
                for (int bj = 0; bj < 2; ++bj) w[m][bj] = *(const u32x4*)(G + (size_t)(row0 + ai * HALF + m * 16) * D + col0 + bj * HALF);
#pragma unroll
            for (int m = 0; m < 4; ++m)
#pragma unroll
                for (int bj = 0; bj < 2; ++bj) { const u32x4 wv = w[m][bj];
                    const f32x4 g0 = {bflo(wv.x), bfhi(wv.x), bflo(wv.y), bfhi(wv.y)}, g1 = {bflo(wv.z), bfhi(wv.z), bflo(wv.w), bfhi(wv.w)};
                    if (first) {
#pragma unroll
                        for (int j = 0; j < 4; ++j) { acc[ai][bj][m][0][j] *= g0[j]; acc[ai][bj][m][1][j] *= g1[j]; } }
                    else { f32x4 o0, o1;
#pragma unroll
                        for (int j = 0; j < 4; ++j) { o0[j] = acc[ai][bj][m][0][j] * g0[j]; o1[j] = acc[ai][bj][m][1][j] * g1[j]; }
                        *(u32x4*)(O + (size_t)(row0 + ai * HALF + m * 16) * D + col0 + bj * HALF) = pack8(o0, o1); } }
            asm volatile("" ::: "memory"); }
        return first;
    }
};
}

constexpr int RING_BYTES = 131072;
constexpr int MISC_OFF = RING_BYTES + 320;
constexpr int TAB_OFF = RING_BYTES + 1024;
constexpr int LDS_BYTES = 163840;

#define XB_TMO      128
#define XB_XCNT(j)  (256  + 64 * (j))
#define XB_XSUB(j)  (1280 + 64 * (j))
#define XB_XGEN(j)  (2304 + 64 * (j))
#define XB_TOP      3328
#define XB_TOPGEN   3392
#define XCD_BAR_WORDS 3456
#define XB_SPIN_CAP (1u << 18)
__device__ __forceinline__ unsigned xb_ld(unsigned* p)              { return __hip_atomic_load(p, __ATOMIC_RELAXED, __HIP_MEMORY_SCOPE_AGENT); }
__device__ __forceinline__ unsigned xb_add(unsigned* p, unsigned v) { return __hip_atomic_fetch_add(p, v, __ATOMIC_RELAXED, __HIP_MEMORY_SCOPE_AGENT); }
__device__ __forceinline__ unsigned xb_xcc_id() { return (unsigned)__builtin_amdgcn_s_getreg((3 << 11) | 20) & 0xFu; }
#define XB_SPIN(cond, bar) do { unsigned _sp = 0; while (cond) { __builtin_amdgcn_s_sleep(1); \
    if ((++_sp & 255u) == 0u) { if (xb_ld(&(bar)[XB_TMO])) break; if (_sp > XB_SPIN_CAP) { atomicAdd(&(bar)[XB_TMO], 1u); break; } } } } while (0)
struct XcdBarrier { unsigned* bar; unsigned x; volatile LAS unsigned* st; };
__device__ __forceinline__ XcdBarrier xcd_barrier_post(unsigned* bar, volatile LAS unsigned* st) {
    XcdBarrier b; b.bar = bar; b.x = xb_xcc_id(); b.st = st;
    if (threadIdx.x == 0) (void)xb_add(&bar[XB_XCNT(b.x)], 1u);
    return b;
}
__device__ __forceinline__ void xcd_barrier_complete(unsigned* bar, unsigned x, unsigned& nloc, unsigned& nx) {
    const unsigned G = gridDim.x * gridDim.y * gridDim.z;
    unsigned sum, cnt, mine, sp = 0u;
    for (;;) {
        sum = 0u; cnt = 0u; mine = 0u;
#pragma unroll
        for (unsigned j = 0; j < 16; ++j) { const unsigned c = xb_ld(&bar[XB_XCNT(j)]); sum += c; cnt += (c > 0u) ? 1u : 0u; mine = (j == x) ? c : mine; }
        if (sum == G) break;
        __builtin_amdgcn_s_sleep(1);
        if ((++sp & 255u) == 0u) { if (xb_ld(&bar[XB_TMO])) break; if (sp > XB_SPIN_CAP) { atomicAdd(&bar[XB_TMO], 1u); break; } }
    }
    nloc = mine > 0u ? mine : 1u; nx = cnt > 0u ? cnt : 1u;
}
__device__ __forceinline__ void xcd_barrier(const XcdBarrier& b) {
    asm volatile("s_waitcnt vmcnt(0)" ::: "memory");
    __syncthreads();
    if (threadIdx.x == 0) {
        unsigned* bar = b.bar;
        __builtin_amdgcn_s_waitcnt(0);
        unsigned nloc = b.st[0], nx = b.st[1];
        if (nloc == 0u) { xcd_barrier_complete(bar, b.x, nloc, nx); b.st[0] = nloc; b.st[1] = nx; }
        const unsigned old = xb_add(&bar[XB_XSUB(b.x)], 1u);
        const unsigned gen = old / nloc;
        if (old + 1u == (gen + 1u) * nloc) {
            __builtin_amdgcn_fence(__ATOMIC_RELEASE, "agent");
            asm volatile("s_waitcnt vmcnt(0)" ::: "memory");
            const unsigned og = xb_add(&bar[XB_TOP], 1u);
            const unsigned tg = og / nx;
            if (og + 1u == (tg + 1u) * nx) xb_add(&bar[XB_TOPGEN], 1u);
            else XB_SPIN(xb_ld(&bar[XB_TOPGEN]) == tg, bar);
            __builtin_amdgcn_fence(__ATOMIC_ACQUIRE, "agent");
            xb_add(&bar[XB_XGEN(b.x)], 1u);
            asm volatile("s_waitcnt vmcnt(0)" ::: "memory");
        } else {
            XB_SPIN(xb_ld(&bar[XB_XGEN(b.x)]) == gen, bar);
            __builtin_amdgcn_fence(__ATOMIC_ACQUIRE, "agent");
            asm volatile("s_waitcnt vmcnt(0)" ::: "memory");
        }
    }
    __syncthreads();
}

__device__ __forceinline__ void wait_counter_ge(unsigned* word, unsigned want) {
    if (threadIdx.x < 64) {
        unsigned sp = 0u;
        while ((unsigned)__builtin_amdgcn_readfirstlane(__hip_atomic_load(word, __ATOMIC_RELAXED, __HIP_MEMORY_SCOPE_AGENT)) < want) { __builtin_amdgcn_s_sleep(2); if (++sp > (1u << 21)) break; }
        __builtin_amdgcn_fence(__ATOMIC_ACQUIRE, "agent");
        asm volatile("s_waitcnt vmcnt(0)" ::: "memory");
    }
    __syncthreads();
}

#define LDS_WAIT() asm volatile("s_waitcnt lgkmcnt(0)" ::: "memory")
__device__ __forceinline__ float wave_sum(float v) {
#pragma unroll
    for (int o = 1; o < 64; o <<= 1) v += __shfl_xor(v, o);
    return v;
}
__device__ __forceinline__ float silu_f(float x) { return x / (1.f + __expf(-x)); }

__device__ __forceinline__ void gemv_partials(const float* cvec, const float* wada, float* part, int G, int wave, int lane) {
    const int task = wave * G + (int)blockIdx.x;
    if (task >= 72 * 16) return;
    const int cgp = task % 72, ks = task / 72, k0 = ks * 128;
    const float sc0 = silu_f(cvec[k0 + lane]), sc1 = silu_f(cvec[k0 + 64 + lane]);
    const float* wp = wada + (size_t)k0 * NMOD + cgp * 256 + lane * 4;
    f32x4 a0 = {0.f, 0.f, 0.f, 0.f}, a1 = a0;
#pragma unroll 16
    for (int kk = 0; kk < 64; ++kk) { const f32x4 w = __builtin_nontemporal_load((const f32x4*)(wp + (size_t)kk * NMOD)); a0 += w * __shfl(sc0, kk); }
#pragma unroll 16
    for (int kk = 0; kk < 64; ++kk) { const f32x4 w = __builtin_nontemporal_load((const f32x4*)(wp + (size_t)(64 + kk) * NMOD)); a1 += w * __shfl(sc1, kk); }
    *(f32x4*)(part + (size_t)ks * NMOD + cgp * 256 + lane * 4) = a0 + a1;
}
__device__ __forceinline__ void mod_reduce(const float* part, const float* bada, float* mod) {
    const int col = (int)blockIdx.x * 512 + (int)threadIdx.x;
    if (col >= NMOD) return;
    float s = bada[col];
#pragma unroll
    for (int ks = 0; ks < 16; ++ks) s += part[(size_t)ks * NMOD + col];
    mod[col] = s;
}
__device__ __forceinline__ f32x4 mod_vec4(const float* part, const float* bada, int mi, int col) {
    f32x4 s = *(const f32x4*)(bada + mi * D + col);
#pragma unroll
    for (int ks = 0; ks < 16; ++ks) s += *(const f32x4*)(part + (size_t)ks * NMOD + mi * D + col);
    return s;
}
struct CvItem { const float* W; bf16* WT; float* bpart; const LAS float* sh; int N, ldt, dst_row0, k0, n0; };
__device__ __forceinline__ void cv_load(const CvItem& c, f32x4 (&v)[8], int lane) {
    const int kk = lane >> 3, q = lane & 7;
#pragma unroll
    for (int i = 0; i < 8; ++i) v[i] = __builtin_nontemporal_load((const f32x4*)(c.W + (size_t)(c.k0 + 8 * i + kk) * c.N + c.n0 + 4 * q));
}
__device__ __forceinline__ void cv_finish(const CvItem& c, const f32x4 (&v)[8], LAS float* scr, int lane) {
    const int kk = lane >> 3, q = lane & 7;
#pragma unroll
    for (int i = 0; i < 8; ++i) { LAS float* s = scr + (8 * i + kk) * 33 + 4 * q; s[0] = v[i][0]; s[1] = v[i][1]; s[2] = v[i][2]; s[3] = v[i][3]; }
    if (c.bpart != nullptr) {
        f32x4 bs = {0.f, 0.f, 0.f, 0.f};
#pragma unroll
        for (int i = 0; i < 8; ++i) { const float shv = c.sh[c.k0 + 8 * i + kk];
#pragma unroll
            for (int j = 0; j < 4; ++j) bs[j] += v[i][j] * shv; }
#pragma unroll
        for (int j = 0; j < 4; ++j) { bs[j] += __shfl_xor(bs[j], 8); bs[j] += __shfl_xor(bs[j], 16); bs[j] += __shfl_xor(bs[j], 32); }
        if (kk == 0) *(f32x4*)(c.bpart + c.dst_row0 + 4 * q) = bs;
    }
    LDS_WAIT(); asm volatile("" ::: "memory");
    const int cc = lane & 7;
#pragma unroll
    for (int j = 0; j < 4; ++j) { const int n = (lane >> 3) + 8 * j; const LAS float* s = scr + (8 * cc) * 33 + n;
        u32x4 o; o.x = pk2(s[0 * 33], s[1 * 33]); o.y = pk2(s[2 * 33], s[3 * 33]); o.z = pk2(s[4 * 33], s[5 * 33]); o.w = pk2(s[6 * 33], s[7 * 33]);
        *(u32x4*)(c.WT + (size_t)(c.dst_row0 + n) * c.ldt + c.k0 + 8 * cc) = o; }
    LDS_WAIT(); asm volatile("" ::: "memory");
}
__device__ __forceinline__ int in_row(int n0) { if (n0 < 2304) return n0; const int o = n0 - 2304, g = o >= D ? 1 : 0, jj = o - g * D; return 2304 + (jj >> 7) * 256 + g * 128 + (jj & 127); }
__device__ __forceinline__ int gu_row(int n0) { const int half = n0 >= FF ? 1 : 0, jj = n0 - half * FF; return (jj >> 7) * 256 + half * 128 + (jj & 127); }

struct Ptrs {
    const float *x, *c, *w_ada, *b_ada, *g_ffn1, *w_gu1, *w_d1, *g_mix, *w_in, *pool_mix, *pool_scale, *w_pu, *q_gain, *k_gain, *sinks, *rel_bias, *w_au, *w_o, *g_ffn2, *w_gu2, *w_d2;
    float* out; unsigned char* ws;
};

__device__ __forceinline__ CvItem cv_desc(const Ptrs& P, int r, const LAS float* sh3, const LAS float* sh6) {
    unsigned char* ws = P.ws; CvItem c; c.bpart = nullptr; c.sh = sh3;
    constexpr int I_GU = (D / 64) * (2 * FF / 32), I_DN = (FF / 64) * (D / 32), I_IN = (D / 64) * (INW / 32), I_PM = 4 * (256 / 64) * (256 / 32), I_UP = (1024 / 64) * (D / 32);
    if (r < I_GU) { const int nblk = 2 * FF / 32, kb = r / nblk, nb = r % nblk;
        c.W = P.w_gu1; c.N = 2 * FF; c.WT = (bf16*)(ws + WS_WGU1); c.ldt = D; c.dst_row0 = gu_row(nb * 32); c.k0 = kb * 64; c.n0 = nb * 32; return c; }
    r -= I_GU;
    if (r < I_GU) { const int nblk = 2 * FF / 32, kb = r / nblk, nb = r % nblk;
        c.W = P.w_gu2; c.N = 2 * FF; c.WT = (bf16*)(ws + WS_WGU2); c.ldt = D; c.dst_row0 = gu_row(nb * 32); c.k0 = kb * 64; c.n0 = nb * 32; c.sh = sh6; c.bpart = (float*)(ws + WS_BPGU) + (size_t)kb * (2 * FF); return c; }
    r -= I_GU;
    if (r < 2 * I_DN) { const bool second = r >= I_DN; if (second) r -= I_DN; const int nblk = D / 32, kb = r / nblk, nb = r % nblk;
        c.W = second ? P.w_d2 : P.w_d1; c.N = D; c.WT = (bf16*)(ws + (second ? WS_WD2 : WS_WD1)); c.ldt = FF; c.dst_row0 = nb * 32; c.k0 = kb * 64; c.n0 = nb * 32; return c; }
    r -= 2 * I_DN;
    if (r < I_IN) { const int nblk = INW / 32, kb = r / nblk, nb = r % nblk;
        c.W = P.w_in; c.N = INW; c.WT = (bf16*)(ws + WS_WIN); c.ldt = D; c.dst_row0 = in_row(nb * 32); c.k0 = kb * 64; c.n0 = nb * 32; c.bpart = (float*)(ws + WS_BPIN) + (size_t)kb * INW; return c; }
    r -= I_IN;
    if (r < I_PM) { const int g = r / 32, rr = r % 32, kb = rr / 8, nb = rr % 8;
        c.W = P.pool_mix + (size_t)g * 65536; c.N = 256; c.WT = (bf16*)(ws + WS_WPM) + (size_t)g * 65536; c.ldt = 256; c.dst_row0 = nb * 32; c.k0 = kb * 64; c.n0 = nb * 32; return c; }
    r -= I_PM;
    if (r < 2 * I_UP) { const bool second = r >= I_UP; if (second) r -= I_UP; const int nblk = D / 32, kb = r / nblk, nb = r % nblk;
        c.W = second ? P.w_au : P.w_pu; c.N = D; c.WT = (bf16*)(ws + (second ? WS_WAU : WS_WPU)); c.ldt = 1024; c.dst_row0 = nb * 32; c.k0 = kb * 64; c.n0 = nb * 32; return c; }
    r -= 2 * I_UP;
    { const int nblk = D / 32, kb = r / nblk, nb = r % nblk;
        c.W = P.w_o; c.N = D; c.WT = (bf16*)(ws + WS_WO); c.ldt = D; c.dst_row0 = nb * 32; c.k0 = kb * 64; c.n0 = nb * 32; return c; }
}
constexpr int CV_I_GU1 = (D / 64) * (2 * FF / 32);
constexpr int CV_NITEMS = 2 * CV_I_GU1 + 2 * (FF / 64) * (D / 32) + (D / 64) * (INW / 32) + 4 * (256 / 64) * (256 / 32) + 2 * (1024 / 64) * (D / 32) + (D / 64) * (D / 32);
__device__ __forceinline__ void convert_weights(const Ptrs& P, LAS unsigned char* lds, int lo, int hi, int gw, int NGW, int wave, int lane, const LAS float* sh3, const LAS float* sh6) {
    LAS float* scr = (LAS float*)(lds + wave * 16384);
    f32x4 va[8], vb[8], vc[8];
    int it = lo + gw;
    if (it >= hi) return;
    CvItem ia = cv_desc(P, it, sh3, sh6), ib = ia, ic = ia;
    cv_load(ia, va, lane);
    bool hb = (it + NGW) < hi, hc = (it + 2 * NGW) < hi;
    if (hb) { ib = cv_desc(P, it + NGW, sh3, sh6); cv_load(ib, vb, lane); }
    if (hc) { ic = cv_desc(P, it + 2 * NGW, sh3, sh6); cv_load(ic, vc, lane); }
#pragma unroll 1
    for (;;) {
        cv_finish(ia, va, scr, lane);
        if (!hb) break;
        { const int n = it + 3 * NGW; const bool h = n < hi; if (h) { ia = cv_desc(P, n, sh3, sh6); cv_load(ia, va, lane); }
          cv_finish(ib, vb, scr, lane);
          if (!hc) break;
          const int n2 = it + 4 * NGW; const bool h2 = n2 < hi; if (h2) { ib = cv_desc(P, n2, sh3, sh6); cv_load(ib, vb, lane); }
          cv_finish(ic, vc, scr, lane);
          if (!h) break;
          const int n3 = it + 5 * NGW; const bool h3 = n3 < hi; if (h3) { ic = cv_desc(P, n3, sh3, sh6); cv_load(ic, vc, lane); }
          it = n; hb = h2; hc = h3; }
    }
}

__device__ __forceinline__ void normmod_phase(const float* src, const LAS float* ta, const LAS float* tb, bf16* dst, int gw, int NGW, int lane) {
    f32x4 av[8], bv[8];
#pragma unroll
    for (int j = 0; j < 8; ++j) { const int col = 4 * lane + 256 * j; av[j] = *(const LAS f32x4*)(ta + col); bv[j] = *(const LAS f32x4*)(tb + col); }
    for (int m = gw; m < S; m += 2 * NGW) {
        const int m2 = m + NGW;
        const f32x4* xr = (const f32x4*)(src + (size_t)m * D) + lane; const f32x4* xr2 = (const f32x4*)(src + (size_t)m2 * D) + lane;
        f32x4 v[8], v2[8]; float ss = 0.f, ss2 = 0.f;
#pragma unroll
        for (int j = 0; j < 8; ++j) { v[j] = __builtin_nontemporal_load(xr + 64 * j); v2[j] = __builtin_nontemporal_load(xr2 + 64 * j); }
#pragma unroll
        for (int j = 0; j < 8; ++j) { ss += (v[j][0] * v[j][0] + v[j][1] * v[j][1]) + (v[j][2] * v[j][2] + v[j][3] * v[j][3]); ss2 += (v2[j][0] * v2[j][0] + v2[j][1] * v2[j][1]) + (v2[j][2] * v2[j][2] + v2[j][3] * v2[j][3]); }
        const float rstd = 1.0f / sqrtf(wave_sum(ss) * (1.0f / D) + EPS), rstd2 = 1.0f / sqrtf(wave_sum(ss2) * (1.0f / D) + EPS);
        u32x2* o8 = (u32x2*)(dst + (size_t)m * D) + lane; u32x2* o82 = (u32x2*)(dst + (size_t)m2 * D) + lane;
#pragma unroll
        for (int j = 0; j < 8; ++j) { const f32x4 o = v[j] * rstd * av[j] + bv[j]; u32x2 w; w.x = pk2(o[0], o[1]); w.y = pk2(o[2], o[3]); o8[64 * j] = w;
            const f32x4 o2 = v2[j] * rstd2 * av[j] + bv[j]; u32x2 w2; w2.x = pk2(o2[0], o2[1]); w2.y = pk2(o2[2], o2[3]); o82[64 * j] = w2; }
    }
}
__device__ __forceinline__ void bias_reduce(const float* bpin, const float* bpgu, float* bwin, float* bwgu) {
    const int t = (int)blockIdx.x * 512 + (int)threadIdx.x;
    if (t < INW) { float s = 0.f;
#pragma unroll 8
        for (int kb = 0; kb < 32; ++kb) s += bpin[(size_t)kb * INW + t];
        bwin[t] = s; }
    else if (t < INW + 2 * FF) { const int n = t - INW; float s = 0.f;
#pragma unroll 8
        for (int kb = 0; kb < 32; ++kb) s += bpgu[(size_t)kb * (2 * FF) + n];
        bwgu[n] = s; }
}

__device__ __forceinline__ void pooled_tile(const float* U, bf16* pooled, int pm, int g) {
    const int tid = threadIdx.x, cq = tid & 63, rc = tid >> 6, r0 = pm * 256 + rc * 32, col = g * 256 + cq * 4, w = 2 << g;
    const float* up = U + col;
    f32x4 sum = {0.f, 0.f, 0.f, 0.f};
    for (int i = 1; i < w; ++i) { const int r = r0 - i; if (r >= 0) sum += *(const f32x4*)(up + (size_t)r * PW); }
    for (int r = r0; r < r0 + 32; ++r) {
        const f32x4 cur = *(const f32x4*)(up + (size_t)r * PW);
        sum += cur;
        const float inv = 1.0f / (float)((r + 1) < w ? (r + 1) : w);
        const f32x4 o = sum * inv - cur;
        u32x2 pw; pw.x = pk2(o[0], o[1]); pw.y = pk2(o[2], o[3]);
        *(u32x2*)(pooled + (size_t)r * PW + col) = pw;
        const int ro = r - w + 1; if (ro >= 0) sum -= *(const f32x4*)(up + (size_t)ro * PW);
    }
}

constexpr int AT_KS = 0, AT_KROW = 144, AT_VT = 256 * 144, AT_VROW = 160, AT_BT = AT_VT + 256 * 160;
typedef short at_v4i16 __attribute__((ext_vector_type(4)));
__device__ __forceinline__ int t5_bucket(int n) {
    if (n < 16) return n;
    int b = 16;
    b += (n >= 19) + (n >= 21) + (n >= 24) + (n >= 27) + (n >= 31) + (n >= 35) + (n >= 40) + (n >= 46) + (n >= 52) + (n >= 59) + (n >= 67) + (n >= 77) + (n >= 87) + (n >= 99) + (n >= 113);
    return b;
}
__device__ __forceinline__ void attn_unit(int nb, int h, const bf16* Q, const bf16* Kb, const bf16* Vb, bf16* O, const float* q_gain, const float* k_gain, const float* sinks, const float* rel_bias, LAS unsigned char* lds) {
    const int tid = threadIdx.x, lane = tid & 63, w = __builtin_amdgcn_readfirstlane(tid >> 6), c = lane & 15, g = lane >> 4;
    const int kvh = h >> 3;
    {
        const int row = tid >> 1, half = tid & 1; const int kpos = (nb - 1) * 128 + row;
        u32x4 kr[4], vr[4];
        if (kpos >= 0) {
            const u32x4* kp = (const u32x4*)(Kb + (size_t)kpos * KVW + kvh * 64 + half * 32); const u32x4* vp = (const u32x4*)(Vb + (size_t)kpos * KVW + kvh * 64 + half * 32);
#pragma unroll
            for (int i = 0; i < 4; ++i) { kr[i] = kp[i]; vr[i] = vp[i]; }
        } else {
#pragma unroll
            for (int i = 0; i < 4; ++i) { kr[i] = (u32x4){0u, 0u, 0u, 0u}; vr[i] = (u32x4){0u, 0u, 0u, 0u}; }
        }
        float kf[32]; float ss = 0.f;
#pragma unroll
        for (int i = 0; i < 4; ++i)
#pragma unroll
            for (int e = 0; e < 4; ++e) { const unsigned wd = kr[i][e]; kf[8 * i + 2 * e] = bflo(wd); kf[8 * i + 2 * e + 1] = bfhi(wd); }
#pragma unroll
        for (int i = 0; i < 32; ++i) ss += kf[i] * kf[i];
        ss += __shfl_xor(ss, 1);
        const float rstd = 1.0f / sqrtf(ss * (1.0f / 64.0f) + EPS);
        LAS unsigned char* kdst = lds + AT_KS + row * AT_KROW + half * 64;
#pragma unroll
        for (int i = 0; i < 4; ++i) { u32x4 o;
#pragma unroll
            for (int e = 0; e < 4; ++e) { const int d = half * 32 + 8 * i + 2 * e; o[e] = pk2(kf[8 * i + 2 * e] * rstd * k_gain[d], kf[8 * i + 2 * e + 1] * rstd * k_gain[d + 1]); }
            *(LAS u32x4*)(kdst + 16 * i) = o; }
        LAS unsigned char* vdst = lds + AT_VT + row * AT_VROW + half * 64;
#pragma unroll
        for (int i = 0; i < 4; ++i) *(LAS u32x4*)(vdst + 16 * i) = vr[i];
        if (tid < 128) ((LAS float*)(lds + AT_BT))[tid] = rel_bias[t5_bucket(tid) * NH + h] * LOG2E;
    }
    const int qrow = nb * 128 + w * 16 + c;
    bf16x8 qf[2];
    {
        const u32x4 q0 = *(const u32x4*)(Q + (size_t)qrow * AW + h * 64 + 8 * g), q1 = *(const u32x4*)(Q + (size_t)qrow * AW + h * 64 + 32 + 8 * g);
        float f0[8], f1[8]; float ss = 0.f;
#pragma unroll
        for (int e = 0; e < 4; ++e) { f0[2 * e] = bflo(q0[e]); f0[2 * e + 1] = bfhi(q0[e]); f1[2 * e] = bflo(q1[e]); f1[2 * e + 1] = bfhi(q1[e]); }
#pragma unroll
        for (int e = 0; e < 8; ++e) ss += f0[e] * f0[e] + f1[e] * f1[e];
        ss += __shfl_xor(ss, 16); ss += __shfl_xor(ss, 32);
        const float rs = (1.0f / sqrtf(ss * (1.0f / 64.0f) + EPS)) * (0.125f * LOG2E);
        u32x4 p0, p1;
#pragma unroll
        for (int e = 0; e < 4; ++e) { const int d = 8 * g + 2 * e; p0[e] = pk2(f0[2 * e] * rs * q_gain[d], f0[2 * e + 1] * rs * q_gain[d + 1]); p1[e] = pk2(f1[2 * e] * rs * q_gain[32 + d], f1[2 * e + 1] * rs * q_gain[32 + d + 1]); }
        qf[0] = __builtin_bit_cast(bf16x8, p0); qf[1] = __builtin_bit_cast(bf16x8, p1);
    }
    const float sink2 = sinks[h] * LOG2E;
    LDS_WAIT(); __syncthreads();
    f32x4 sv[9];
    const LAS float* bt = (const LAS float*)(lds + AT_BT);
    float mx = sink2;
#pragma unroll
    for (int kb = 0; kb < 9; ++kb) {
        const int krow = 16 * (w + kb) + c;
        const bf16x8 k0 = *(const LAS bf16x8*)(lds + AT_KS + krow * AT_KROW + 16 * g), k1 = *(const LAS bf16x8*)(lds + AT_KS + krow * AT_KROW + 64 + 16 * g);
        f32x4 a = {0.f, 0.f, 0.f, 0.f};
        a = __builtin_amdgcn_mfma_f32_16x16x32_bf16(k0, qf[0], a, 0, 0, 0);
        a = __builtin_amdgcn_mfma_f32_16x16x32_bf16(k1, qf[1], a, 0, 0, 0);
#pragma unroll
        for (int r = 0; r < 4; ++r) {
            const int dist = 128 + c - 16 * kb - 4 * g - r;
            const int j = 16 * (w + kb) + 4 * g + r;
            const bool ok = (dist >= 0) && (dist < 128) && (nb > 0 || j >= 128);
            const float lg = a[r] + bt[dist & 127];
            a[r] = ok ? lg : -1e30f;
            mx = fmaxf(mx, a[r]);
        }
        sv[kb] = a;
    }
    mx = fmaxf(mx, __shfl_xor(mx, 16)); mx = fmaxf(mx, __shfl_xor(mx, 32));
    float lsum = 0.f;
#pragma unroll
    for (int kb = 0; kb < 9; ++kb)
#pragma unroll
        for (int r = 0; r < 4; ++r) { const float p = __builtin_amdgcn_exp2f(sv[kb][r] - mx); sv[kb][r] = p; lsum += p; }
    lsum += __shfl_xor(lsum, 16); lsum += __shfl_xor(lsum, 32);
    lsum += __builtin_amdgcn_exp2f(sink2 - mx);
    const float inv = 1.0f / lsum;
    f32x4 oacc[4];
#pragma unroll
    for (int db = 0; db < 4; ++db) oacc[db] = (f32x4){0.f, 0.f, 0.f, 0.f};
    LAS unsigned char* vtr = lds + AT_VT + (4 * g + (c >> 2)) * AT_VROW + 8 * (c & 3);
#pragma unroll
    for (int ks = 0; ks < 5; ++ks) {
        u32x4 pw; pw.x = pk2(sv[2 * ks][0], sv[2 * ks][1]); pw.y = pk2(sv[2 * ks][2], sv[2 * ks][3]);
        if (ks < 4) { pw.z = pk2(sv[2 * ks + 1][0], sv[2 * ks + 1][1]); pw.w = pk2(sv[2 * ks + 1][2], sv[2 * ks + 1][3]); } else { pw.z = 0u; pw.w = 0u; }
        const bf16x8 pf = __builtin_bit_cast(bf16x8, pw);
        const int kb0 = w + 2 * ks, kb1r = w + 2 * ks + 1, kb1 = kb1r > 15 ? 15 : kb1r;
#pragma unroll
        for (int db = 0; db < 4; ++db) {
            const at_v4i16 lo = __builtin_amdgcn_ds_read_tr16_b64_v4i16((LAS at_v4i16*)(vtr + kb0 * (16 * AT_VROW) + 32 * db)), hi = __builtin_amdgcn_ds_read_tr16_b64_v4i16((LAS at_v4i16*)(vtr + kb1 * (16 * AT_VROW) + 32 * db));
            const u32x2 l2 = __builtin_bit_cast(u32x2, lo), h2 = __builtin_bit_cast(u32x2, hi);
            const u32x4 vw = {l2.x, l2.y, h2.x, h2.y};
            oacc[db] = __builtin_amdgcn_mfma_f32_16x16x32_bf16(__builtin_bit_cast(bf16x8, vw), pf, oacc[db], 0, 0, 0);
        }
    }
#pragma unroll
    for (int db = 0; db < 4; ++db) { u32x2 ow; ow.x = pk2(oacc[db][0] * inv, oacc[db][1] * inv); ow.y = pk2(oacc[db][2] * inv, oacc[db][3] * inv);
        *(u32x2*)(O + (size_t)qrow * AW + h * 64 + 16 * db + 4 * g) = ow; }
    LDS_WAIT(); __syncthreads();
}

struct Args { const float* in[21]; float* out; unsigned char* ws; };
__global__ void __launch_bounds__(512, 2) mega_fwd(Args args) {
    extern __shared__ __attribute__((aligned(16))) unsigned char lds_raw[];
    LAS unsigned char* lds = (LAS unsigned char*)lds_raw;
    const int tid = threadIdx.x, lane = tid & 63, wave = __builtin_amdgcn_readfirstlane(tid >> 6);
    const int G = gridDim.x, bx = blockIdx.x;
    const int vcu = (G % 8 == 0) ? (bx % 8) * (G / 8) + bx / 8 : bx;
    const int gw = vcu * 8 + wave, NGW = G * 8;
    Ptrs P;
    P.x = args.in[0]; P.c = args.in[1]; P.w_ada = args.in[2]; P.b_ada = args.in[3]; P.g_ffn1 = args.in[4]; P.w_gu1 = args.in[5]; P.w_d1 = args.in[6]; P.g_mix = args.in[7];
    P.w_in = args.in[8]; P.pool_mix = args.in[9]; P.pool_scale = args.in[10]; P.w_pu = args.in[11]; P.q_gain = args.in[12]; P.k_gain = args.in[13]; P.sinks = args.in[14];
    P.rel_bias = args.in[15]; P.w_au = args.in[16]; P.w_o = args.in[17]; P.g_ffn2 = args.in[18]; P.w_gu2 = args.in[19]; P.w_d2 = args.in[20]; P.out = args.out; P.ws = args.ws;
    unsigned char* ws = args.ws;
    unsigned* ctl = (unsigned*)(ws + WS_CTL);
    float* modp = (float*)(ws + WS_MODP); float* mod = (float*)(ws + WS_MOD); float* bwin = (float*)(ws + WS_BWIN); float* bwgu = (float*)(ws + WS_BWGU); float* rowp = (float*)(ws + WS_ROWP);
    bf16* Hb = (bf16*)(ws + WS_H); bf16* ACT = (bf16*)(ws + WS_ACT);
    float* Ub = (float*)(ws + WS_U); bf16* Qb = (bf16*)(ws + WS_Q); bf16* Kb = (bf16*)(ws + WS_K); bf16* Vb = (bf16*)(ws + WS_V);
    bf16* GA = (bf16*)(ws + WS_GA); bf16* GB = (bf16*)(ws + WS_GB); bf16* POOLED = (bf16*)(ws + WS_POOLED); bf16* MIXED = (bf16*)(ws + WS_MIXED); bf16* ATT = (bf16*)(ws + WS_ATT); bf16* MERGED = (bf16*)(ws + WS_MERGED); bf16* HX = (bf16*)(ws + WS_HX);

    volatile LAS unsigned* MISC = (volatile LAS unsigned*)(lds + MISC_OFF);
    if (tid < 64) ((LAS unsigned*)(lds + RING_BYTES))[tid + 64] = 0u;
    __syncthreads();
    XcdBarrier bar = xcd_barrier_post(ctl + CW_BAR, MISC + 8);
#define GRID_BAR() xcd_barrier(bar)

    if ((PHASE_MASK >> 0) & 1) gemv_partials(P.c, P.w_ada, modp, G, wave, lane);
    GRID_BAR();
    if ((PHASE_MASK >> 1) & 1) {
        mod_reduce(modp, P.b_ada, mod);
        LAS float* ta = (LAS float*)lds; LAS float* tb = ta + D;
        { const int col = 4 * tid; const f32x4 shv = mod_vec4(modp, P.b_ada, 0, col), scv = mod_vec4(modp, P.b_ada, 1, col), g = *(const f32x4*)(P.g_ffn1 + col);
          *(LAS f32x4*)(ta + col) = g * (scv + 1.0f); *(LAS f32x4*)(tb + col) = shv;
 }
        LDS_WAIT(); __syncthreads();
        normmod_phase(P.x, ta, tb, Hb, gw, NGW, lane);
        LDS_WAIT(); __syncthreads();
        convert_weights(P, lds, 0, CV_I_GU1, gw, NGW, wave, lane, nullptr, nullptr);
    }
    GRID_BAR();
    if ((PHASE_MASK >> 2) & 1) {
        const int kslot = ((bx >> 3) * 6) >> 5;
        LAS float* sh3 = (LAS float*)(lds + TAB_OFF); LAS float* sh6 = sh3 + D;
        *(LAS f32x4*)(sh3 + 4 * tid) = *(const f32x4*)(mod + 3 * D + 4 * tid); *(LAS f32x4*)(sh6 + 4 * tid) = *(const f32x4*)(mod + 6 * D + 4 * tid);
        LDS_WAIT(); __syncthreads();
        pg8::EpiSwiglu<false> E{ACT, FF, nullptr, nullptr};
        if (kslot > 0) { pg8::Sched Sc; Sc.init(S, 2 * FF, G, bx, Hb, ws + WS_WGU1, D, D); Sc.mode = 1; Sc.split_round = 5; Sc.split_mod = 128; Sc.r_hi = kslot;
            pg8::gemm_phase<pg8::EpiSwiglu<false>, true, true>(lds, D, D, D, Sc, E, ctl + CW_PANEL); }
        convert_weights(P, lds, CV_I_GU1, CV_NITEMS, gw, NGW, wave, lane, sh3, sh6);
        asm volatile("s_waitcnt vmcnt(0)" ::: "memory"); __syncthreads();
        if (tid == 0) { __builtin_amdgcn_fence(__ATOMIC_RELEASE, "agent"); asm volatile("s_waitcnt vmcnt(0)" ::: "memory");
            __hip_atomic_fetch_add(ctl + CW_CVDONE, 1u, __ATOMIC_RELAXED, __HIP_MEMORY_SCOPE_AGENT); }
        { pg8::Sched Sc; Sc.init(S, 2 * FF, G, bx, Hb, ws + WS_WGU1, D, D); Sc.mode = 1; Sc.split_round = 5; Sc.split_mod = 128; Sc.r_lo = kslot;
            pg8::gemm_phase<pg8::EpiSwiglu<false>, true, true>(lds, D, D, D, Sc, E, ctl + CW_PANEL); }
    }
    if ((PHASE_MASK >> 3) & 1) {
        pg8::Sched Sc; Sc.init(S, D, G, bx, ACT, ws + WS_WD1, FF, FF); Sc.mode = 2; pg8::EpiResid<true, true> E{P.x, P.out, mod + 2 * D, P.g_mix, mod + 4 * D, HX, rowp};
        wait_counter_ge(ctl + CW_CVDONE, (unsigned)G);
        bias_reduce((const float*)(ws + WS_BPIN), (const float*)(ws + WS_BPGU), bwin, bwgu);
        { pg8::Unit u0; (void)Sc.next(0, u0); wait_counter_ge(ctl + CW_PANEL + 64 * u0.pm, 44u * 8u * 2u); }
        pg8::gemm_phase<pg8::EpiResid<true, true>, false>(lds, FF, FF, FF, Sc, E);
    }
    GRID_BAR();
    if ((PHASE_MASK >> 4) & 1) {
        pg8::Sched Sc; Sc.init(S, INW, G, bx, HX, ws + WS_WIN, D, D); Sc.r_hi = 3; pg8::EpiIn E{Ub, Qb, Kb, Vb, GA, GB, rowp, bwin};
        pg8::gemm_phase<pg8::EpiIn, true>(lds, D, D, D, Sc, E);
    }
    GRID_BAR();
    if ((PHASE_MASK >> 5) & 1) {
        if (bx < 64) {
            pg8::Sched Sc; Sc.init(S, INW, G, bx, HX, ws + WS_WIN, D, D); Sc.r_lo = 3; Sc.split_round = 3; Sc.split_mod = 32; pg8::EpiIn E{Ub, Qb, Kb, Vb, GA, GB, rowp, bwin};
            pg8::gemm_phase<pg8::EpiIn, true>(lds, D, D, D, Sc, E);
        } else if (bx < 192) {
            pg8::Sched Sc; Sc.init(S, PW, 128, bx - 64, POOLED, ws + WS_WPM, PW, 256, 256 * 2);
            pg8::Unit u0; (void)Sc.next(0, u0);
            pooled_tile(Ub, POOLED, u0.pm, u0.pn);
            asm volatile("s_waitcnt vmcnt(0)" ::: "memory"); __syncthreads();
            if (tid == 0) { __builtin_amdgcn_fence(__ATOMIC_ACQUIRE, "agent"); asm volatile("s_waitcnt vmcnt(0)" ::: "memory"); }
            __syncthreads();
            pg8::EpiPoolMix E{MIXED, P.pool_scale};
            pg8::gemm_phase<pg8::EpiPoolMix, false>(lds, 256, PW, 256, Sc, E);
        }
        for (;;) {
            if (tid == 0) MISC[0] = __hip_atomic_fetch_add(ctl + CW_QHEAD, 1u, __ATOMIC_RELAXED, __HIP_MEMORY_SCOPE_AGENT);
            __syncthreads();
            const int uid = (int)MISC[0];
            __syncthreads();
            if (uid >= 1024) break;
            const int hh = uid & 7, grp = uid >> 3, kvh = grp & 1, nb = grp >> 1;
            attn_unit(nb, kvh * 8 + hh, Qb, Kb, Vb, ATT, P.q_gain, P.k_gain, P.sinks, P.rel_bias, lds);
        }
    }
    GRID_BAR();
    if ((PHASE_MASK >> 6) & 1) {
        pg8::Sched Sc; Sc.init(S, D, G, bx, MIXED, ws + WS_WPU, PW, PW, 0, ATT, ws + WS_WAU); pg8::EpiMerge E{GA, GB, MERGED};
        pg8::gemm_phase<pg8::EpiMerge, false>(lds, PW, PW, PW, Sc, E);
    }
    GRID_BAR();
    if ((PHASE_MASK >> 7) & 1) {
        pg8::Sched Sc; Sc.init(S, D, G, bx, MERGED, ws + WS_WO, D, D); pg8::EpiResid<true, false> E{P.out, P.out, mod + 5 * D, P.g_ffn2, mod + 7 * D, Hb, rowp};
        pg8::gemm_phase<pg8::EpiResid<true, false>, false>(lds, D, D, D, Sc, E);
    }
    GRID_BAR();
    if ((PHASE_MASK >> 8) & 1) {
        pg8::Sched Sc; Sc.init(S, 2 * FF, G, bx, Hb, ws + WS_WGU2, D, D); Sc.mode = 1; Sc.split_round = 5; Sc.split_mod = 128; pg8::EpiSwiglu<true> E{ACT, FF, rowp, bwgu};
        pg8::gemm_phase<pg8::EpiSwiglu<true>, true, true>(lds, D, D, D, Sc, E, ctl + CW_PANEL + 32 * 64);
    }
    if ((PHASE_MASK >> 9) & 1) {
        pg8::Sched Sc; Sc.init(S, D, G, bx, ACT, ws + WS_WD2, FF, FF); Sc.mode = 2; pg8::EpiResid<false, true> E{P.out, P.out, mod + 8 * D, nullptr, nullptr, nullptr, nullptr};
        { pg8::Unit u0; (void)Sc.next(0, u0); wait_counter_ge(ctl + CW_PANEL + 32 * 64 + 64 * u0.pm, 44u * 8u * 2u); }
        pg8::gemm_phase<pg8::EpiResid<false, true>, false>(lds, FF, FF, FF, Sc, E);
    }
#undef GRID_BAR
}

extern "C" void kernel_launch(void* const* d_in, const int* in_sizes, int n_in, void* d_out, int out_size, void* d_ws, size_t ws_size, hipStream_t stream) {
    static int grid = 0;
    if (grid == 0) {
        if (n_in != 21 || in_sizes[0] != S * D || out_size != S * D || ws_size < WS_END) { fprintf(stderr, "kernel_launch: unexpected shapes (n_in %d, in0 %d, out %d, ws %zu < %zu)\n", n_in, n_in > 0 ? in_sizes[0] : -1, out_size, ws_size, (size_t)WS_END); grid = -1; return; }
        int dev = 0, cus = 0, per_cu = 0;
        if (hipGetDevice(&dev) != hipSuccess || hipDeviceGetAttribute(&cus, hipDeviceAttributeMultiprocessorCount, dev) != hipSuccess) { grid = -1; return; }
        if (hipFuncSetAttribute((const void*)mega_fwd, hipFuncAttributeMaxDynamicSharedMemorySize, LDS_BYTES) != hipSuccess) { fprintf(stderr, "kernel_launch: hipFuncSetAttribute failed\n"); grid = -1; return; }
        if (hipOccupancyMaxActiveBlocksPerMultiprocessor(&per_cu, (const void*)mega_fwd, 512, LDS_BYTES) != hipSuccess || per_cu < 1) { fprintf(stderr, "kernel_launch: occupancy query says %d blocks per CU\n", per_cu); grid = -1; return; }
        (void)hipGetLastError();
        grid = cus;
        if (grid != 256) { fprintf(stderr, "kernel_launch: built for a 256-CU device, found %d CUs\n", cus); grid = -1; return; }
    }
    if (grid < 0) return;
    (void)hipMemsetAsync((char*)d_ws + WS_CTL, 0, CTL_ZERO_BYTES, stream);
    Args a{};
    for (int i = 0; i < 21; ++i) a.in[i] = (const float*)d_in[i];
    a.out = (float*)d_out; a.ws = (unsigned char*)d_ws;
    void* kargs[] = {&a};
    hipError_t e = hipLaunchCooperativeKernel((const void*)mega_fwd, dim3(grid), dim3(512), kargs, LDS_BYTES, stream);
    if (e != hipSuccess) fprintf(stderr, "kernel_launch: cooperative launch failed: %s (grid %d)\n", hipGetErrorString(e), grid);
}
```

```cpp
#include <hip/hip_runtime.h>
#include <cstdio>
#include <cstdint>


#ifndef PHASE_MASK
#define PHASE_MASK 0xFFFF
#endif
#define LAS __attribute__((address_space(3)))
typedef unsigned short bf16;
typedef short bf16x8 __attribute__((ext_vector_type(8)));
typedef short s16x4 __attribute__((ext_vector_type(4)));
typedef float f32x4 __attribute__((ext_vector_type(4)));
typedef float f32x2 __attribute__((ext_vector_type(2)));
typedef unsigned u32x4 __attribute__((ext_vector_type(4)));
typedef unsigned u32x2 __attribute__((ext_vector_type(2)));
typedef __bf16 bf16x2_t __attribute__((ext_vector_type(2)));

__device__ __forceinline__ unsigned pk2(float lo, float hi) { f32x2 v = {lo, hi}; bf16x2_t b = __builtin_convertvector(v, bf16x2_t); return __builtin_bit_cast(unsigned, b); }
__device__ __forceinline__ float bflo(unsigned w) { return __uint_as_float(w << 16); }
__device__ __forceinline__ float bfhi(unsigned w) { return __uint_as_float(w & 0xffff0000u); }
__device__ __forceinline__ float sigmoid_f(float x) { return __builtin_amdgcn_rcpf(1.f + __builtin_amdgcn_exp2f(-1.4426950408889634f * x)); }

constexpr int S = 8192, D = 2048, FF = 5632, INW = 6400, PW = 1024, AW = 1024, KVW = 128, NH = 16, HD = 64;
constexpr int NMOD = 9 * D;
constexpr float EPS = 1e-6f;
constexpr float LOG2E = 1.4426950408889634f;

constexpr size_t MiB = 1u << 20;
constexpr size_t WS_CTL = 0, CTL_ZERO_BYTES = 64 * 1024;
constexpr size_t WS_MODP = 1 * MiB;
constexpr size_t WS_MOD = 2 * MiB + 512 * 1024;
constexpr size_t WS_BWIN = WS_MOD + 128 * 1024, WS_BWGU = WS_MOD + 192 * 1024;
constexpr size_t WS_ROWP = 3 * MiB;
constexpr size_t WS_BPIN = 4 * MiB;
constexpr size_t WS_BPGU = 5 * MiB;
constexpr size_t WS_WGU1 = 8 * MiB;
constexpr size_t WS_WD1 = WS_WGU1 + 44 * MiB;
constexpr size_t WS_WIN = WS_WD1 + 22 * MiB;
constexpr size_t WS_WPM = WS_WIN + 25 * MiB;
constexpr size_t WS_WPU = WS_WPM + 1 * MiB;
constexpr size_t WS_WAU = WS_WPU + 4 * MiB;
constexpr size_t WS_WO = WS_WAU + 4 * MiB;
constexpr size_t WS_WGU2 = WS_WO + 8 * MiB;
constexpr size_t WS_WD2 = WS_WGU2 + 44 * MiB;
constexpr size_t WS_H = WS_WD2 + 22 * MiB;
constexpr size_t WS_BIG = WS_H + 32 * MiB;
constexpr size_t WS_ACT = WS_BIG;
constexpr size_t WS_U = WS_BIG;
constexpr size_t WS_Q = WS_U + 32 * MiB;
constexpr size_t WS_K = WS_Q + 16 * MiB;
constexpr size_t WS_V = WS_K + 2 * MiB;
constexpr size_t WS_GA = WS_V + 2 * MiB;
constexpr size_t WS_GB = WS_GA + 32 * MiB;
constexpr size_t WS_POOLED = WS_GB + 32 * MiB;
constexpr size_t WS_MIXED = WS_POOLED + 16 * MiB;
constexpr size_t WS_ATT = WS_MIXED + 16 * MiB;
constexpr size_t WS_MERGED = WS_ATT + 16 * MiB;
constexpr size_t WS_HX = WS_MERGED + 32 * MiB;
constexpr size_t WS_END = WS_HX + 32 * MiB;
static_assert(WS_ACT + (size_t)S * FF * 2 <= WS_END, "act fits in the big region");
constexpr int CW_BAR = 1024, CW_QHEAD = 8192, CW_CVDONE = 8256, CW_PANEL = 12288;

namespace pg8 {
constexpr int BM = 256, BK = 64, HALF = 128, HTB = HALF * BK * 2, STAGE_BYTES = 8 * HTB, NXCD = 8, WGM = 8;
__device__ __forceinline__ int lds_byte(int r, int c) { const int st = (r >> 4) * 2 + (c >> 5), rr = r & 15, cc = c & 31, ob = rr * 64 + cc * 2; return st * 1024 + (ob ^ (((ob >> 9) & 1) << 5)); }
__device__ __forceinline__ void stage_rc(int b, int& R, int& C) { const int st = b / 1024, sb = b % 1024, swz = sb ^ (((sb >> 9) & 1) << 5); R = (st >> 1) * 16 + swz / 64; C = (st & 1) * 32 + (swz % 64) / 2; }
__device__ __forceinline__ int perm32(int rho) { const int n = rho >> 4, i = rho & 15; return 8 * (i >> 2) + 4 * n + (i & 3); }

struct Unit { int pm, pn, kind, rowbase, halfm; const char* A; const char* B; };

struct Sched {
    int split_round, split_mod;
    int nM, nN, nwg, G, c, dual, r_lo, r_hi, mode;
    const char *A0, *B0, *A1, *B1; size_t a_tile, b_tile, a_pn;
    __device__ __forceinline__ void init(int M, int N, int G_, int c_, const void* A0_, const void* B0_, size_t lda, size_t ldb, size_t a_pn_bytes = 0, const void* A1_ = nullptr, const void* B1_ = nullptr) {
        nM = M / BM; nN = N / BM; nwg = nM * nN; G = G_; c = c_; dual = (A1_ != nullptr); r_lo = 0; r_hi = 1 << 30; mode = 0; split_round = 1 << 30; split_mod = 1;
        A0 = (const char*)A0_; B0 = (const char*)B0_; A1 = (const char*)A1_; B1 = (const char*)B1_;
        a_tile = (size_t)BM * lda * 2; b_tile = (size_t)BM * ldb * 2; a_pn = a_pn_bytes;
    }
    __device__ __forceinline__ bool next(int i, Unit& u) const {
        const int ti = (dual ? (i >> 1) : i) + r_lo; if (ti >= r_hi || ti > split_round) return false;
        const bool hs = (ti == split_round);
        const long L = (long)ti * G + (hs ? c % split_mod : c); if (L >= nwg) return false;
        u.halfm = hs ? 1 : 0;
        if (mode == 2) {
            if (i > 0) return false;
            const int x = c & 7, j = c >> 3, early = j >= 16 ? 1 : 0, jj = j & 15;
            u.pm = 8 * (x >> 1) + (early ? 0 : 4) + 2 * (x & 1) + (jj >> 3); u.pn = jj & 7;
        } else {
        int wgid = (int)L; { const int q = nwg / NXCD, r = nwg % NXCD, xcd = wgid % NXCD, off = wgid / NXCD; wgid = (xcd < r ? xcd * (q + 1) : r * (q + 1) + (xcd - r) * q) + off; }
        const int nig = WGM * nN, gid = wgid / nig, fm = gid * WGM, gsz = (nM - fm) < WGM ? (nM - fm) : WGM;
        if (mode == 1) {
            const int idx = wgid % nig, hf = idx / 176, off = idx % 176, sec = off / 88, o2 = off % 88;
            u.pm = fm + 4 * sec + (o2 & 3); u.pn = 22 * hf + (o2 >> 2);
        } else { u.pm = fm + ((wgid % nig) % gsz); u.pn = (wgid % nig) / gsz; }
        }
        const int sub = dual ? (i & 1) : 0; u.kind = dual ? (1 + sub) : 0;
        u.rowbase = u.pm * BM + (hs ? (c / split_mod) * HALF : 0);
        u.A = (sub ? A1 : A0) + (size_t)u.pm * a_tile + (size_t)u.pn * a_pn + (hs ? (size_t)(c / split_mod) * (a_tile / 2) : 0);
        u.B = (sub ? B1 : B0) + (size_t)u.pn * b_tile;
        return true;
    }
};

template <class Epi, bool ALIGN_EPI, bool PUB = false>
__device__ __forceinline__ void gemm_phase(LAS unsigned char* lds, const int K, const int lda, const int ldb, const Sched& S, const Epi& E, unsigned* ctr = nullptr) {
    int tid_ = threadIdx.x; asm volatile("" : "+v"(tid_));
    const int tid = tid_, wid = __builtin_amdgcn_readfirstlane(tid >> 6), lane = tid & 63, wr = wid >> 2, wc = wid & 3, fr = lane & 15, fq = lane >> 4;
    const int nt = K / BK;
    unsigned voffA[2], voffB[2];
#pragma unroll
    for (int i = 0; i < 2; ++i) { int R, C; stage_rc(tid * 16 + i * 8192, R, C); const int Rb = (R & ~31) + perm32(R & 31);
        voffA[i] = (unsigned)(R * lda + C) * 2u; voffB[i] = (unsigned)(Rb * ldb + C) * 2u; }
    const size_t kstep = (size_t)(BK * 2);
    const size_t hstepA_full = (size_t)HALF * lda * 2, hstepB = (size_t)HALF * ldb * 2;
    const unsigned ldsw = (unsigned)wid * 1024u;
    const int aoff = lds_byte(wr * 64 + fr, fq * 8), boff = lds_byte(wc * 32 + fr, fq * 8);
#define PG8_SA(b, h) (((b) * 2 + (h)) * HTB)
#define PG8_SB(b, h) ((4 + (b) * 2 + (h)) * HTB)
#define PG8_STAGE(bufoff, gbase, voff) do { _Pragma("unroll") for (int _i = 0; _i < 2; ++_i) \
        __builtin_amdgcn_global_load_lds((const unsigned*)((const char*)(gbase) + (voff)[_i]), (LAS unsigned*)(lds + (bufoff) + ldsw + _i * 8192), 16, 0, 0); } while (0)
#define PG8_LDA(dst, b, h) do { _Pragma("unroll") for (int m = 0; m < 4; ++m) _Pragma("unroll") for (int k = 0; k < 2; ++k) dst[m][k] = *(const LAS bf16x8*)(lds + PG8_SA(b, h) + aoff + m * 2048 + k * 1024); } while (0)
#define PG8_LDB(dst, b, h) do { _Pragma("unroll") for (int n = 0; n < 2; ++n) _Pragma("unroll") for (int k = 0; k < 2; ++k) dst[n][k] = *(const LAS bf16x8*)(lds + PG8_SB(b, h) + boff + n * 2048 + k * 1024); } while (0)
#define PG8_MMA(ai, bj, At, Bt) do { __builtin_amdgcn_s_setprio(1); _Pragma("unroll") for (int m = 0; m < 4; ++m) _Pragma("unroll") for (int n = 0; n < 2; ++n) _Pragma("unroll") for (int k = 0; k < 2; ++k) \
        acc[ai][bj][m][n] = __builtin_amdgcn_mfma_f32_16x16x32_bf16(Bt[n][k], At[m][k], acc[ai][bj][m][n], 0, 0, 0); __builtin_amdgcn_s_setprio(0); } while (0)
#define PG8_WAIT_V(n) asm volatile("s_waitcnt vmcnt(" #n ")" ::: "memory")
#define PG8_WAIT_L(n) asm volatile("s_waitcnt lgkmcnt(" #n ")" ::: "memory")
#define PG8_BAR __builtin_amdgcn_s_barrier()
#define PG8_SCHED __builtin_amdgcn_sched_barrier(0)
    Unit cur, nxt; int ui = 0; int pend_pm = -1; unsigned pend_n = 0u;
    if (!S.next(0, cur)) return;
    f32x4 acc[2][2][4][2];
#pragma unroll
    for (int a = 0; a < 2; ++a)
#pragma unroll
        for (int b = 0; b < 2; ++b)
#pragma unroll
            for (int m = 0; m < 4; ++m)
#pragma unroll
                for (int n = 0; n < 2; ++n) acc[a][b][m][n] = (f32x4){0.f, 0.f, 0.f, 0.f};
    bf16x8 At[4][2], B0[2][2], B1[2][2];
    const char* cA = cur.A; const char* cB = cur.B;
    size_t hstepA = cur.halfm ? 0 : hstepA_full;
    PG8_STAGE(PG8_SB(0, 0), cB, voffB); PG8_STAGE(PG8_SB(0, 1), cB + hstepB, voffB); PG8_STAGE(PG8_SA(0, 0), cA, voffA); PG8_STAGE(PG8_SA(0, 1), cA + hstepA, voffA);
    if (wr == 1) PG8_BAR;
    PG8_WAIT_V(2); PG8_BAR;
    PG8_STAGE(PG8_SB(1, 0), cB + kstep, voffB); PG8_STAGE(PG8_SA(1, 0), cA + kstep, voffA); PG8_STAGE(PG8_SB(1, 1), cB + hstepB + kstep, voffB);
    PG8_WAIT_V(6); PG8_BAR;
    for (;;) {
        const bool has_next = S.next(ui + 1, nxt);
        const char* nA = has_next ? nxt.A : cA; const char* nB = has_next ? nxt.B : cB;
        const size_t hstepA_n = has_next ? (nxt.halfm ? 0 : hstepA_full) : hstepA; const bool fullm = !cur.halfm;
#pragma unroll 1
        for (int t = 0; t < nt; t += 2) {
            const bool last = (t == nt - 2);
            const char* a1 = cA + (size_t)(t + 1) * kstep;
            const char* a2 = last ? nA : cA + (size_t)(t + 2) * kstep; const char* b2 = last ? nB : cB + (size_t)(t + 2) * kstep;
            const char* a3 = a2 + kstep; const char* b3 = b2 + kstep;
            PG8_LDB(B0, 0, 0); PG8_LDB(B1, 0, 1); PG8_SCHED; PG8_LDA(At, 0, 0); PG8_STAGE(PG8_SA(1, 1), a1 + hstepA, voffA);
            PG8_WAIT_V(8); PG8_WAIT_L(0); PG8_BAR; PG8_MMA(0, 0, At, B0); PG8_MMA(0, 1, At, B1); PG8_BAR; PG8_SCHED;
            if (fullm) PG8_LDA(At, 0, 1); PG8_STAGE(PG8_SB(0, 0), b2, voffB); PG8_STAGE(PG8_SB(0, 1), b2 + hstepB, voffB); PG8_STAGE(PG8_SA(0, 0), a2, voffA);
            PG8_WAIT_V(8); PG8_WAIT_L(0); PG8_BAR; if (fullm) { PG8_MMA(1, 0, At, B0); PG8_MMA(1, 1, At, B1); } PG8_BAR; PG8_SCHED;
            PG8_LDB(B0, 1, 0); PG8_LDB(B1, 1, 1); PG8_SCHED; PG8_LDA(At, 1, 0); PG8_STAGE(PG8_SA(0, 1), a2 + (last ? hstepA_n : hstepA), voffA);
            PG8_WAIT_V(8); PG8_WAIT_L(0); PG8_BAR; PG8_MMA(0, 0, At, B0); PG8_MMA(0, 1, At, B1); PG8_BAR; PG8_SCHED;
            if (fullm) PG8_LDA(At, 1, 1); PG8_STAGE(PG8_SB(1, 0), b3, voffB); PG8_STAGE(PG8_SB(1, 1), b3 + hstepB, voffB); PG8_STAGE(PG8_SA(1, 0), a3, voffA);
            PG8_WAIT_V(8); PG8_WAIT_L(0); PG8_BAR; if (fullm) { PG8_MMA(1, 0, At, B0); PG8_MMA(1, 1, At, B1); } PG8_BAR; PG8_SCHED;
        }
        if constexpr (ALIGN_EPI) { if (wr == 0) PG8_BAR; }
        if constexpr (PUB) {
            if (pend_n != 0u && cur.pm != pend_pm) { PG8_WAIT_V(0); if (lane == 0) __hip_atomic_fetch_add(ctr + 64 * pend_pm, pend_n, __ATOMIC_RELAXED, __HIP_MEMORY_SCOPE_AGENT); pend_n = 0u; }
            pend_pm = cur.pm; pend_n += cur.halfm ? 1u : 2u; }
        const bool keep = E(acc, cur, wr, wc, fr, fq);
        if (!has_next) break;
        if (!keep) {
#pragma unroll
            for (int a = 0; a < 2; ++a)
#pragma unroll
                for (int b = 0; b < 2; ++b)
#pragma unroll
                    for (int m = 0; m < 4; ++m)
#pragma unroll
                        for (int n = 0; n < 2; ++n) acc[a][b][m][n] = (f32x4){0.f, 0.f, 0.f, 0.f};
        }
        cur = nxt; cA = nA; cB = nB; hstepA = hstepA_n; ++ui;
        if constexpr (ALIGN_EPI) { if (wr == 1) PG8_BAR; }
    }
    PG8_WAIT_V(0);
    if constexpr (PUB) { if (pend_n != 0u && lane == 0) __hip_atomic_fetch_add(ctr + 64 * pend_pm, pend_n, __ATOMIC_RELAXED, __HIP_MEMORY_SCOPE_AGENT); }
    if constexpr (!ALIGN_EPI) { if (wr == 0) PG8_BAR; }
    PG8_BAR;
#undef PG8_SA
#undef PG8_SB
#undef PG8_STAGE
#undef PG8_LDA
#undef PG8_LDB
#undef PG8_MMA
#undef PG8_WAIT_V
#undef PG8_WAIT_L
#undef PG8_BAR
#undef PG8_SCHED
}

typedef f32x4 (&AccRef)[2][2][4][2];
__device__ __forceinline__ u32x4 pack8(const f32x4 v0, const f32x4 v1) { u32x4 w; w.x = pk2(v0[0], v0[1]); w.y = pk2(v0[2], v0[3]); w.z = pk2(v1[0], v1[1]); w.w = pk2(v1[2], v1[3]); return w; }

__device__ __forceinline__ float row_rstd(const float* rowpart, int row) {
    const f32x4* p = (const f32x4*)(rowpart + (size_t)row * 32);
    f32x4 s4 = p[0];
#pragma unroll
    for (int i = 1; i < 8; ++i) s4 += p[i];
    return 1.0f / sqrtf(((s4[0] + s4[1]) + (s4[2] + s4[3])) * (1.0f / D) + EPS);
}
__device__ __forceinline__ void apply_rs_bias(AccRef acc, const float* rowpart, int rowbase, int fr, const float* bias, int bcol0, int halfm) {
    const int lane = threadIdx.x & 63;
    f32x4 bv[2][2];
#pragma unroll
    for (int bj = 0; bj < 2; ++bj)
#pragma unroll
        for (int n = 0; n < 2; ++n) bv[bj][n] = *(const f32x4*)(bias + bcol0 + bj * HALF + 4 * n);
    float rv[2];
    rv[0] = row_rstd(rowpart, rowbase + lane); rv[1] = halfm ? 1.0f : row_rstd(rowpart, rowbase + HALF + lane);
#pragma unroll
    for (int ai = 0; ai < 2; ++ai)
#pragma unroll
        for (int m = 0; m < 4; ++m) { const float rs = __shfl(rv[ai], m * 16 + fr);
#pragma unroll
            for (int bj = 0; bj < 2; ++bj)
#pragma unroll
                for (int n = 0; n < 2; ++n) acc[ai][bj][m][n] = acc[ai][bj][m][n] * rs + bv[bj][n]; }
}
template <bool NORM> struct EpiSwiglu {
    bf16* O; int ldc; const float* rowpart; const float* bias;
    __device__ __forceinline__ bool operator()(AccRef acc, const Unit& u, int wr, int wc, int fr, int fq) const {
        const int row0 = u.rowbase + wr * 64 + fr, col0 = u.pn * HALF + wc * 32 + 8 * fq;
        if constexpr (NORM) apply_rs_bias(acc, rowpart, u.rowbase + wr * 64, fr, bias, u.pn * BM + wc * 32 + 8 * fq, u.halfm);
        const __amdgpu_buffer_rsrc_t rs_o = __builtin_amdgcn_make_buffer_rsrc(O, 0, S * FF * 2, 0x00020000);
#pragma unroll
        for (int ai = 0; ai < 2; ++ai) if (!(ai == 1 && u.halfm))
#pragma unroll
            for (int m = 0; m < 4; ++m) {
                f32x4 o[2];
#pragma unroll
                for (int n = 0; n < 2; ++n) { const f32x4 g = acc[ai][0][m][n], up = acc[ai][1][m][n];
#pragma unroll
                    for (int j = 0; j < 4; ++j) o[n][j] = g[j] * up[j] * sigmoid_f(g[j]); }
                __builtin_amdgcn_raw_buffer_store_b128(pack8(o[0], o[1]), rs_o, (unsigned)(((row0 + ai * HALF + m * 16) * ldc + col0) * 2), 0,   16);
            }
        return false;
    }
};
template <bool NEXT, bool HALFG> struct EpiResid {
    static constexpr float gsc = HALFG ? 0.5f : 1.0f;
    const float* base; float* out; const float* gate; const float* gn; const float* scn; bf16* XA; float* rowpart;
    __device__ __forceinline__ bool operator()(AccRef acc, const Unit& u, int wr, int wc, int fr, int fq) const {
        const int row0 = u.rowbase + wr * 64 + fr, col0 = u.pn * BM + wc * 32 + 8 * fq;
        f32x4 gv[2][2], an[2][2];
#pragma unroll
        for (int bj = 0; bj < 2; ++bj)
#pragma unroll
            for (int n = 0; n < 2; ++n) { gv[bj][n] = *(const f32x4*)(gate + col0 + bj * HALF + 4 * n) * gsc;
                if constexpr (NEXT) an[bj][n] = *(const f32x4*)(gn + col0 + bj * HALF + 4 * n) * (*(const f32x4*)(scn + col0 + bj * HALF + 4 * n) + 1.0f); }
#pragma unroll
        for (int ai = 0; ai < 2; ++ai)
#pragma unroll
            for (int m = 0; m < 4; ++m) { const int row = row0 + ai * HALF + m * 16; const size_t off = (size_t)row * D + col0; float ss = 0.f;
#pragma unroll
                for (int bj = 0; bj < 2; ++bj) {
                    const f32x4 b0 = *(const f32x4*)(base + off + bj * HALF), b1 = *(const f32x4*)(base + off + bj * HALF + 4);
                    const f32x4 x0 = b0 + gv[bj][0] * acc[ai][bj][m][0], x1 = b1 + gv[bj][1] * acc[ai][bj][m][1];
                    *(f32x4*)(out + off + bj * HALF) = x0; *(f32x4*)(out + off + bj * HALF + 4) = x1;
                    if constexpr (NEXT) {
                        ss += ((x0[0] * x0[0] + x0[1] * x0[1]) + (x0[2] * x0[2] + x0[3] * x0[3])) + ((x1[0] * x1[0] + x1[1] * x1[1]) + (x1[2] * x1[2] + x1[3] * x1[3]));
                        *(u32x4*)(XA + off + bj * HALF) = pack8(x0 * an[bj][0], x1 * an[bj][1]); } }
                if constexpr (NEXT) { ss += __shfl_xor(ss, 16); ss += __shfl_xor(ss, 32); if (fq == 0) rowpart[(size_t)row * 32 + u.pn * 4 + wc] = ss; }
                if (m & 1) asm volatile("" ::: "memory"); }
        return false;
    }
};
struct EpiIn {
    float* U; bf16* Q; bf16* Kb; bf16* Vb; bf16* GA; bf16* GB; const float* rowpart; const float* bias;
    __device__ __forceinline__ bool operator()(AccRef acc, const Unit& u, int wr, int wc, int fr, int fq) const {
        const int row0 = u.rowbase + wr * 64 + fr, cw = wc * 32 + 8 * fq; const int pn = u.pn;
        apply_rs_bias(acc, rowpart, u.rowbase + wr * 64, fr, bias, pn * BM + cw, u.halfm);
        if (pn < 4) {
#pragma unroll
            for (int ai = 0; ai < 2; ++ai) if (!(ai == 1 && u.halfm))
#pragma unroll
                for (int m = 0; m < 4; ++m) { float* rp = U + (size_t)(row0 + ai * HALF + m * 16) * PW + pn * BM + cw;
#pragma unroll
                    for (int bj = 0; bj < 2; ++bj) { *(f32x4*)(rp + bj * HALF) = acc[ai][bj][m][0]; *(f32x4*)(rp + bj * HALF + 4) = acc[ai][bj][m][1]; } }
        } else if (pn < 8) {
#pragma unroll
            for (int ai = 0; ai < 2; ++ai) if (!(ai == 1 && u.halfm))
#pragma unroll
                for (int m = 0; m < 4; ++m) { bf16* rp = Q + (size_t)(row0 + ai * HALF + m * 16) * AW + (pn - 4) * BM + cw;
#pragma unroll
                    for (int bj = 0; bj < 2; ++bj) *(u32x4*)(rp + bj * HALF) = pack8(acc[ai][bj][m][0], acc[ai][bj][m][1]); }
        } else if (pn == 8) {
#pragma unroll
            for (int ai = 0; ai < 2; ++ai) if (!(ai == 1 && u.halfm))
#pragma unroll
                for (int m = 0; m < 4; ++m) { const size_t ro = (size_t)(row0 + ai * HALF + m * 16) * KVW + cw;
                    *(u32x4*)(Kb + ro) = pack8(acc[ai][0][m][0], acc[ai][0][m][1]); *(u32x4*)(Vb + ro) = pack8(acc[ai][1][m][0], acc[ai][1][m][1]); }
        } else {
            const int ct = (pn - 9) * HALF + cw;
#pragma unroll
            for (int ai = 0; ai < 2; ++ai) if (!(ai == 1 && u.halfm))
#pragma unroll
                for (int m = 0; m < 4; ++m) { const size_t ro = (size_t)(row0 + ai * HALF + m * 16) * D + ct; f32x4 r0, r1, s0, s1;
#pragma unroll
                    for (int j = 0; j < 4; ++j) {
                        const float ea0 = __builtin_amdgcn_exp2f(-LOG2E * acc[ai][0][m][0][j]), eb0 = __builtin_amdgcn_exp2f(-LOG2E * acc[ai][1][m][0][j]);
                        const float ea1 = __builtin_amdgcn_exp2f(-LOG2E * acc[ai][0][m][1][j]), eb1 = __builtin_amdgcn_exp2f(-LOG2E * acc[ai][1][m][1][j]);
                        s0[j] = fmaxf(__builtin_amdgcn_rcpf(1.f + eb0), 1e-30f); s1[j] = fmaxf(__builtin_amdgcn_rcpf(1.f + eb1), 1e-30f);
                        r0[j] = __builtin_amdgcn_rcpf(1.f + ea0) * __builtin_amdgcn_rcpf(s0[j]); r1[j] = __builtin_amdgcn_rcpf(1.f + ea1) * __builtin_amdgcn_rcpf(s1[j]); }
                    *(u32x4*)(GA + ro) = pack8(r0, r1); *(u32x4*)(GB + ro) = pack8(s0, s1); asm volatile("" ::: "memory"); }
        }
        return false;
    }
};
struct EpiPoolMix {
    bf16* O; const float* pscale;
    __device__ __forceinline__ bool operator()(AccRef acc, const Unit& u, int wr, int wc, int fr, int fq) const {
        const int row0 = u.rowbase + wr * 64 + fr, col0 = u.pn * BM + wc * 32 + 8 * fq;
        f32x4 sv[2][2];
#pragma unroll
        for (int bj = 0; bj < 2; ++bj)
#pragma unroll
            for (int n = 0; n < 2; ++n) sv[bj][n] = *(const f32x4*)(pscale + col0 + bj * HALF + 4 * n);
#pragma unroll
        for (int ai = 0; ai < 2; ++ai)
#pragma unroll
            for (int m = 0; m < 4; ++m) { bf16* rp = O + (size_t)(row0 + ai * HALF + m * 16) * PW + col0;
#pragma unroll
                for (int bj = 0; bj < 2; ++bj) *(u32x4*)(rp + bj * HALF) = pack8(acc[ai][bj][m][0] * sv[bj][0], acc[ai][bj][m][1] * sv[bj][1]); }
        return false;
    }
};
struct EpiMerge {
    const bf16* R; const bf16* SB; bf16* O;
    __device__ __forceinline__ bool operator()(AccRef acc, const Unit& u, int wr, int wc, int fr, int fq) const {
        const int row0 = u.rowbase + wr * 64 + fr, col0 = u.pn * BM + wc * 32 + 8 * fq;
        const bool first = (u.kind == 1);
        const bf16* G = first ? R : SB;
#pragma unroll
        for (int ai = 0; ai < 2; ++ai) if (!(ai == 1 && u.halfm)) {
            u32x4 w[4][2];
#pragma unroll
            for (int m = 0; m < 4; ++m)
#pragma unroll
                for (int bj = 0; bj < 2; ++bj) w[m][bj] = *(const u32x4*)(G + (size_t)(row0 + ai * HALF + m * 16) * D + col0 + bj * HALF);
#pragma unroll
            for (int m = 0; m < 4; ++m)
#pragma unroll
                for (int bj = 0; bj < 2; ++bj) { const u32x4 wv = w[m][bj];
                    const f32x4 g0 = {bflo(wv.x), bfhi(wv.x), bflo(wv.y), bfhi(wv.y)}, g1 = {bflo(wv.z), bfhi(wv.z), bflo(wv.w), bfhi(wv.w)};
                    if (first) {
#pragma unroll
                        for (int j = 0; j < 4; ++j) { acc[ai][bj][m][0][j] *= g0[j]; acc[ai][bj][m][1][j] *= g1[j]; } }
                    else { f32x4 o0, o1;
#pragma unroll
                        for (int j = 0; j < 4; ++j) { o0[j] = acc[ai][bj][m][0][j] * g0[j]; o1[j] = acc[ai][bj][m][1][j] * g1[j]; }
                        *(u32x4*)(O + (size_t)(row0 + ai * HALF + m * 16) * D + col0 + bj * HALF) = pack8(o0, o1); } }
            asm volatile("" ::: "memory"); }
        return first;
    }
};
}

constexpr int RING_BYTES = 131072;
constexpr int MISC_OFF = RING_BYTES + 320;
constexpr int TAB_OFF = RING_BYTES + 1024;
constexpr int LDS_BYTES = 163840;

#define XB_TMO      128
#define XB_XCNT(j)  (256  + 64 * (j))
#define XB_XSUB(j)  (1280 + 64 * (j))
#define XB_XGEN(j)  (2304 + 64 * (j))
#define XB_TOP      3328
#define XB_TOPGEN   3392
#define XCD_BAR_WORDS 3456
#define XB_SPIN_CAP (1u << 18)
__device__ __forceinline__ unsigned xb_ld(unsigned* p)              { return __hip_atomic_load(p, __ATOMIC_RELAXED, __HIP_MEMORY_SCOPE_AGENT); }
__device__ __forceinline__ unsigned xb_add(unsigned* p, unsigned v) { return __hip_atomic_fetch_add(p, v, __ATOMIC_RELAXED, __HIP_MEMORY_SCOPE_AGENT); }
__device__ __forceinline__ unsigned xb_xcc_id() { return (unsigned)__builtin_amdgcn_s_getreg((3 << 11) | 20) & 0xFu; }
#define XB_SPIN(cond, bar) do { unsigned _sp = 0; while (cond) { __builtin_amdgcn_s_sleep(1); \
    if ((++_sp & 255u) == 0u) { if (xb_ld(&(bar)[XB_TMO])) break; if (_sp > XB_SPIN_CAP) { atomicAdd(&(bar)[XB_TMO], 1u); break; } } } } while (0)
struct XcdBarrier { unsigned* bar; unsigned x; volatile LAS unsigned* st; };
__device__ __forceinline__ XcdBarrier xcd_barrier_post(unsigned* bar, volatile LAS unsigned* st) {
    XcdBarrier b; b.bar = bar; b.x = xb_xcc_id(); b.st = st;
    if (threadIdx.x == 0) (void)xb_add(&bar[XB_XCNT(b.x)], 1u);
    return b;
}
__device__ __forceinline__ void xcd_barrier_complete(unsigned* bar, unsigned x, unsigned& nloc, unsigned& nx) {
    const unsigned G = gridDim.x * gridDim.y * gridDim.z;
    unsigned sum, cnt, mine, sp = 0u;
    for (;;) {
        sum = 0u; cnt = 0u; mine = 0u;
#pragma unroll
        for (unsigned j = 0; j < 16; ++j) { const unsigned c = xb_ld(&bar[XB_XCNT(j)]); sum += c; cnt += (c > 0u) ? 1u : 0u; mine = (j == x) ? c : mine; }
        if (sum == G) break;
        __builtin_amdgcn_s_sleep(1);
        if ((++sp & 255u) == 0u) { if (xb_ld(&bar[XB_TMO])) break; if (sp > XB_SPIN_CAP) { atomicAdd(&bar[XB_TMO], 1u); break; } }
    }
    nloc = mine > 0u ? mine : 1u; nx = cnt > 0u ? cnt : 1u;
}
__device__ __forceinline__ void xcd_barrier(const XcdBarrier& b) {
    asm volatile("s_waitcnt vmcnt(0)" ::: "memory");
    __syncthreads();
    if (threadIdx.x == 0) {
        unsigned* bar = b.bar;
        __builtin_amdgcn_s_waitcnt(0);
        unsigned nloc = b.st[0], nx = b.st[1];
        if (nloc == 0u) { xcd_barrier_complete(bar, b.x, nloc, nx); b.st[0] = nloc; b.st[1] = nx; }
        const unsigned old = xb_add(&bar[XB_XSUB(b.x)], 1u);
        const unsigned gen = old / nloc;
        if (old + 1u == (gen + 1u) * nloc) {
            __builtin_amdgcn_fence(__ATOMIC_RELEASE, "agent");
            asm volatile("s_waitcnt vmcnt(0)" ::: "memory");
            const unsigned og = xb_add(&bar[XB_TOP], 1u);
            const unsigned tg = og / nx;
            if (og + 1u == (tg + 1u) * nx) xb_add(&bar[XB_TOPGEN], 1u);
            else XB_SPIN(xb_ld(&bar[XB_TOPGEN]) == tg, bar);
            __builtin_amdgcn_fence(__ATOMIC_ACQUIRE, "agent");
            xb_add(&bar[XB_XGEN(b.x)], 1u);
            asm volatile("s_waitcnt vmcnt(0)" ::: "memory");
        } else {
            XB_SPIN(xb_ld(&bar[XB_XGEN(b.x)]) == gen, bar);
            __builtin_amdgcn_fence(__ATOMIC_ACQUIRE, "agent");
            asm volatile("s_waitcnt vmcnt(0)" ::: "memory");
        }
    }
    __syncthreads();
}

__device__ __forceinline__ void wait_counter_ge(unsigned* word, unsigned want) {
    if (threadIdx.x < 64) {
        unsigned sp = 0u;
        while ((unsigned)__builtin_amdgcn_readfirstlane(__hip_atomic_load(word, __ATOMIC_RELAXED, __HIP_MEMORY_SCOPE_AGENT)) < want) { __builtin_amdgcn_s_sleep(2); if (++sp > (1u << 21)) break; }
        __builtin_amdgcn_fence(__ATOMIC_ACQUIRE, "agent");
        asm volatile("s_waitcnt vmcnt(0)" ::: "memory");
    }
    __syncthreads();
}

#define LDS_WAIT() asm volatile("s_waitcnt lgkmcnt(0)" ::: "memory")
__device__ __forceinline__ float wave_sum(float v) {
#pragma unroll
    for (int o = 1; o < 64; o <<= 1) v += __shfl_xor(v, o);
    return v;
}
__device__ __forceinline__ float silu_f(float x) { return x / (1.f + __expf(-x)); }

__device__ __forceinline__ void gemv_partials(const float* cvec, const float* wada, float* part, int G, int wave, int lane) {
    const int task = wave * G + (int)blockIdx.x;
    if (task >= 72 * 16) return;
    const int cgp = task % 72, ks = task / 72, k0 = ks * 128;
    const float sc0 = silu_f(cvec[k0 + lane]), sc1 = silu_f(cvec[k0 + 64 + lane]);
    const float* wp = wada + (size_t)k0 * NMOD + cgp * 256 + lane * 4;
    f32x4 a0 = {0.f, 0.f, 0.f, 0.f}, a1 = a0;
#pragma unroll 16
    for (int kk = 0; kk < 64; ++kk) { const f32x4 w = __builtin_nontemporal_load((const f32x4*)(wp + (size_t)kk * NMOD)); a0 += w * __shfl(sc0, kk); }
#pragma unroll 16
    for (int kk = 0; kk < 64; ++kk) { const f32x4 w = __builtin_nontemporal_load((const f32x4*)(wp + (size_t)(64 + kk) * NMOD)); a1 += w * __shfl(sc1, kk); }
    *(f32x4*)(part + (size_t)ks * NMOD + cgp * 256 + lane * 4) = a0 + a1;
}
__device__ __forceinline__ void mod_reduce(const float* part, const float* bada, float* mod) {
    const int col = (int)blockIdx.x * 512 + (int)threadIdx.x;
    if (col >= NMOD) return;
    float s = bada[col];
#pragma unroll
    for (int ks = 0; ks < 16; ++ks) s += part[(size_t)ks * NMOD + col];
    mod[col] = s;
}
__device__ __forceinline__ f32x4 mod_vec4(const float* part, const float* bada, int mi, int col) {
    f32x4 s = *(const f32x4*)(bada + mi * D + col);
#pragma unroll
    for (int ks = 0; ks < 16; ++ks) s += *(const f32x4*)(part + (size_t)ks * NMOD + mi * D + col);
    return s;
}
struct CvItem { const float* W; bf16* WT; float* bpart; const LAS float* sh; int N, ldt, dst_row0, k0, n0; };
__device__ __forceinline__ void cv_load(const CvItem& c, f32x4 (&v)[8], int lane) {
    const int kk = lane >> 3, q = lane & 7;
#pragma unroll
    for (int i = 0; i < 8; ++i) v[i] = __builtin_nontemporal_load((const f32x4*)(c.W + (size_t)(c.k0 + 8 * i + kk) * c.N + c.n0 + 4 * q));
}
__device__ __forceinline__ void cv_finish(const CvItem& c, const f32x4 (&v)[8], LAS float* scr, int lane) {
    const int kk = lane >> 3, q = lane & 7;
#pragma unroll
    for (int i = 0; i < 8; ++i) { LAS float* s = scr + (8 * i + kk) * 33 + 4 * q; s[0] = v[i][0]; s[1] = v[i][1]; s[2] = v[i][2]; s[3] = v[i][3]; }
    if (c.bpart != nullptr) {
        f32x4 bs = {0.f, 0.f, 0.f, 0.f};
#pragma unroll
        for (int i = 0; i < 8; ++i) { const float shv = c.sh[c.k0 + 8 * i + kk];
#pragma unroll
            for (int j = 0; j < 4; ++j) bs[j] += v[i][j] * shv; }
#pragma unroll
        for (int j = 0; j < 4; ++j) { bs[j] += __shfl_xor(bs[j], 8); bs[j] += __shfl_xor(bs[j], 16); bs[j] += __shfl_xor(bs[j], 32); }
        if (kk == 0) *(f32x4*)(c.bpart + c.dst_row0 + 4 * q) = bs;
    }
    LDS_WAIT(); asm volatile("" ::: "memory");
    const int cc = lane & 7;
#pragma unroll
    for (int j = 0; j < 4; ++j) { const int n = (lane >> 3) + 8 * j; const LAS float* s = scr + (8 * cc) * 33 + n;
        u32x4 o; o.x = pk2(s[0 * 33], s[1 * 33]); o.y = pk2(s[2 * 33], s[3 * 33]); o.z = pk2(s[4 * 33], s[5 * 33]); o.w = pk2(s[6 * 33], s[7 * 33]);
        *(u32x4*)(c.WT + (size_t)(c.dst_row0 + n) * c.ldt + c.k0 + 8 * cc) = o; }
    LDS_WAIT(); asm volatile("" ::: "memory");
}
__device__ __forceinline__ int in_row(int n0) { if (n0 < 2304) return n0; const int o = n0 - 2304, g = o >= D ? 1 : 0, jj = o - g * D; return 2304 + (jj >> 7) * 256 + g * 128 + (jj & 127); }
__device__ __forceinline__ int gu_row(int n0) { const int half = n0 >= FF ? 1 : 0, jj = n0 - half * FF; return (jj >> 7) * 256 + half * 128 + (jj & 127); }

struct Ptrs {
    const float *x, *c, *w_ada, *b_ada, *g_ffn1, *w_gu1, *w_d1, *g_mix, *w_in, *pool_mix, *pool_scale, *w_pu, *q_gain, *k_gain, *sinks, *rel_bias, *w_au, *w_o, *g_ffn2, *w_gu2, *w_d2;
    float* out; unsigned char* ws;
};

__device__ __forceinline__ CvItem cv_desc(const Ptrs& P, int r, const LAS float* sh3, const LAS float* sh6) {
    unsigned char* ws = P.ws; CvItem c; c.bpart = nullptr; c.sh = sh3;
    constexpr int I_GU = (D / 64) * (2 * FF / 32), I_DN = (FF / 64) * (D / 32), I_IN = (D / 64) * (INW / 32), I_PM = 4 * (256 / 64) * (256 / 32), I_UP = (1024 / 64) * (D / 32);
    if (r < I_GU) { const int nblk = 2 * FF / 32, kb = r / nblk, nb = r % nblk;
        c.W = P.w_gu1; c.N = 2 * FF; c.WT = (bf16*)(ws + WS_WGU1); c.ldt = D; c.dst_row0 = gu_row(nb * 32); c.k0 = kb * 64; c.n0 = nb * 32; return c; }
    r -= I_GU;
    if (r < I_GU) { const int nblk = 2 * FF / 32, kb = r / nblk, nb = r % nblk;
        c.W = P.w_gu2; c.N = 2 * FF; c.WT = (bf16*)(ws + WS_WGU2); c.ldt = D; c.dst_row0 = gu_row(nb * 32); c.k0 = kb * 64; c.n0 = nb * 32; c.sh = sh6; c.bpart = (float*)(ws + WS_BPGU) + (size_t)kb * (2 * FF); return c; }
    r -= I_GU;
    if (r < 2 * I_DN) { const bool second = r >= I_DN; if (second) r -= I_DN; const int nblk = D / 32, kb = r / nblk, nb = r % nblk;
        c.W = second ? P.w_d2 : P.w_d1; c.N = D; c.WT = (bf16*)(ws + (second ? WS_WD2 : WS_WD1)); c.ldt = FF; c.dst_row0 = nb * 32; c.k0 = kb * 64; c.n0 = nb * 32; return c; }
    r -= 2 * I_DN;
    if (r < I_IN) { const int nblk = INW / 32, kb = r / nblk, nb = r % nblk;
        c.W = P.w_in; c.N = INW; c.WT = (bf16*)(ws + WS_WIN); c.ldt = D; c.dst_row0 = in_row(nb * 32); c.k0 = kb * 64; c.n0 = nb * 32; c.bpart = (float*)(ws + WS_BPIN) + (size_t)kb * INW; return c; }
    r -= I_IN;
    if (r < I_PM) { const int g = r / 32, rr = r % 32, kb = rr / 8, nb = rr % 8;
        c.W = P.pool_mix + (size_t)g * 65536; c.N = 256; c.WT = (bf16*)(ws + WS_WPM) + (size_t)g * 65536; c.ldt = 256; c.dst_row0 = nb * 32; c.k0 = kb * 64; c.n0 = nb * 32; return c; }
    r -= I_PM;
    if (r < 2 * I_UP) { const bool second = r >= I_UP; if (second) r -= I_UP; const int nblk = D / 32, kb = r / nblk, nb = r % nblk;
        c.W = second ? P.w_au : P.w_pu; c.N = D; c.WT = (bf16*)(ws + (second ? WS_WAU : WS_WPU)); c.ldt = 1024; c.dst_row0 = nb * 32; c.k0 = kb * 64; c.n0 = nb * 32; return c; }
    r -= 2 * I_UP;
    { const int nblk = D / 32, kb = r / nblk, nb = r % nblk;
        c.W = P.w_o; c.N = D; c.WT = (bf16*)(ws + WS_WO); c.ldt = D; c.dst_row0 = nb * 32; c.k0 = kb * 64; c.n0 = nb * 32; return c; }
}
constexpr int CV_I_GU1 = (D / 64) * (2 * FF / 32);
constexpr int CV_NITEMS = 2 * CV_I_GU1 + 2 * (FF / 64) * (D / 32) + (D / 64) * (INW / 32) + 4 * (256 / 64) * (256 / 32) + 2 * (1024 / 64) * (D / 32) + (D / 64) * (D / 32);
__device__ __forceinline__ void convert_weights(const Ptrs& P, LAS unsigned char* lds, int lo, int hi, int gw, int NGW, int wave, int lane, const LAS float* sh3, const LAS float* sh6) {
    LAS float* scr = (LAS float*)(lds + wave * 16384);
    f32x4 va[8], vb[8], vc[8];
    int it = lo + gw;
    if (it >= hi) return;
    CvItem ia = cv_desc(P, it, sh3, sh6), ib = ia, ic = ia;
    cv_load(ia, va, lane);
    bool hb = (it + NGW) < hi, hc = (it + 2 * NGW) < hi;
    if (hb) { ib = cv_desc(P, it + NGW, sh3, sh6); cv_load(ib, vb, lane); }
    if (hc) { ic = cv_desc(P, it + 2 * NGW, sh3, sh6); cv_load(ic, vc, lane); }
#pragma unroll 1
    for (;;) {
        cv_finish(ia, va, scr, lane);
        if (!hb) break;
        { const int n = it + 3 * NGW; const bool h = n < hi; if (h) { ia = cv_desc(P, n, sh3, sh6); cv_load(ia, va, lane); }
          cv_finish(ib, vb, scr, lane);
          if (!hc) break;
          const int n2 = it + 4 * NGW; const bool h2 = n2 < hi; if (h2) { ib = cv_desc(P, n2, sh3, sh6); cv_load(ib, vb, lane); }
          cv_finish(ic, vc, scr, lane);
          if (!h) break;
          const int n3 = it + 5 * NGW; const bool h3 = n3 < hi; if (h3) { ic = cv_desc(P, n3, sh3, sh6); cv_load(ic, vc, lane); }
          it = n; hb = h2; hc = h3; }
    }
}

__device__ __forceinline__ void normmod_phase(const float* src, const LAS float* ta, const LAS float* tb, bf16* dst, int gw, int NGW, int lane) {
    f32x4 av[8], bv[8];
#pragma unroll
    for (int j = 0; j < 8; ++j) { const int col = 4 * lane + 256 * j; av[j] = *(const LAS f32x4*)(ta + col); bv[j] = *(const LAS f32x4*)(tb + col); }
    for (int m = gw; m < S; m += 2 * NGW) {
        const int m2 = m + NGW;
        const f32x4* xr = (const f32x4*)(src + (size_t)m * D) + lane; const f32x4* xr2 = (const f32x4*)(src + (size_t)m2 * D) + lane;
        f32x4 v[8], v2[8]; float ss = 0.f, ss2 = 0.f;
#pragma unroll
        for (int j = 0; j < 8; ++j) { v[j] = __builtin_nontemporal_load(xr + 64 * j); v2[j] = __builtin_nontemporal_load(xr2 + 64 * j); }
#pragma unroll
        for (int j = 0; j < 8; ++j) { ss += (v[j][0] * v[j][0] + v[j][1] * v[j][1]) + (v[j][2] * v[j][2] + v[j][3] * v[j][3]); ss2 += (v2[j][0] * v2[j][0] + v2[j][1] * v2[j][1]) + (v2[j][2] * v2[j][2] + v2[j][3] * v2[j][3]); }
        const float rstd = 1.0f / sqrtf(wave_sum(ss) * (1.0f / D) + EPS), rstd2 = 1.0f / sqrtf(wave_sum(ss2) * (1.0f / D) + EPS);
        u32x2* o8 = (u32x2*)(dst + (size_t)m * D) + lane; u32x2* o82 = (u32x2*)(dst + (size_t)m2 * D) + lane;
#pragma unroll
        for (int j = 0; j < 8; ++j) { const f32x4 o = v[j] * rstd * av[j] + bv[j]; u32x2 w; w.x = pk2(o[0], o[1]); w.y = pk2(o[2], o[3]); o8[64 * j] = w;
            const f32x4 o2 = v2[j] * rstd2 * av[j] + bv[j]; u32x2 w2; w2.x = pk2(o2[0], o2[1]); w2.y = pk2(o2[2], o2[3]); o82[64 * j] = w2; }
    }
}
__device__ __forceinline__ void bias_reduce(const float* bpin, const float* bpgu, float* bwin, float* bwgu) {
    const int t = (int)blockIdx.x * 512 + (int)threadIdx.x;
    if (t < INW) { float s = 0.f;
#pragma unroll 8
        for (int kb = 0; kb < 32; ++kb) s += bpin[(size_t)kb * INW + t];
        bwin[t] = s; }
    else if (t < INW + 2 * FF) { const int n = t - INW; float s = 0.f;
#pragma unroll 8
        for (int kb = 0; kb < 32; ++kb) s += bpgu[(size_t)kb * (2 * FF) + n];
        bwgu[n] = s; }
}

__device__ __forceinline__ void pooled_tile(const float* U, bf16* pooled, int pm, int g) {
    const int tid = threadIdx.x, cq = tid & 63, rc = tid >> 6, r0 = pm * 256 + rc * 32, col = g * 256 + cq * 4, w = 2 << g;
    const float* up = U + col;
    f32x4 sum = {0.f, 0.f, 0.f, 0.f};
    for (int i = 1; i < w; ++i) { const int r = r0 - i; if (r >= 0) sum += *(const f32x4*)(up + (size_t)r * PW); }
#pragma unroll 1
    for (int rb = r0; rb < r0 + 32; rb += 8) {
        f32x4 cu[8], ol[8];
#pragma unroll
        for (int j = 0; j < 8; ++j) { const int r = rb + j, ro = r - w + 1; cu[j] = *(const f32x4*)(up + (size_t)r * PW);
            if (ro >= 0) ol[j] = *(const f32x4*)(up + (size_t)ro * PW); else ol[j] = (f32x4){0.f, 0.f, 0.f, 0.f}; }
#pragma unroll
        for (int j = 0; j < 8; ++j) { const int r = rb + j;
            sum += cu[j];
            const float inv = 1.0f / (float)((r + 1) < w ? (r + 1) : w);
            const f32x4 o = sum * inv - cu[j];
            u32x2 pw; pw.x = pk2(o[0], o[1]); pw.y = pk2(o[2], o[3]);
            *(u32x2*)(pooled + (size_t)r * PW + col) = pw;
            sum -= ol[j]; }
    }
}

constexpr int AT_KS = 0, AT_KROW = 144, AT_VT = 256 * 144, AT_VROW = 160, AT_BT = AT_VT + 256 * 160;
typedef short at_v4i16 __attribute__((ext_vector_type(4)));
__device__ __forceinline__ int t5_bucket(int n) {
    if (n < 16) return n;
    int b = 16;
    b += (n >= 19) + (n >= 21) + (n >= 24) + (n >= 27) + (n >= 31) + (n >= 35) + (n >= 40) + (n >= 46) + (n >= 52) + (n >= 59) + (n >= 67) + (n >= 77) + (n >= 87) + (n >= 99) + (n >= 113);
    return b;
}
__device__ __forceinline__ void attn_unit(int nb, int h, const bf16* Q, const bf16* Kb, const bf16* Vb, bf16* O, const float* q_gain, const float* k_gain, const float* sinks, const float* rel_bias, LAS unsigned char* lds) {
    const int tid = threadIdx.x, lane = tid & 63, w = __builtin_amdgcn_readfirstlane(tid >> 6), c = lane & 15, g = lane >> 4;
    const int kvh = h >> 3;
    {
        const int row = tid >> 1, half = tid & 1; const int kpos = (nb - 1) * 128 + row;
        u32x4 kr[4], vr[4];
        if (kpos >= 0) {
            const u32x4* kp = (const u32x4*)(Kb + (size_t)kpos * KVW + kvh * 64 + half * 32); const u32x4* vp = (const u32x4*)(Vb + (size_t)kpos * KVW + kvh * 64 + half * 32);
#pragma unroll
            for (int i = 0; i < 4; ++i) { kr[i] = kp[i]; vr[i] = vp[i]; }
        } else {
#pragma unroll
            for (int i = 0; i < 4; ++i) { kr[i] = (u32x4){0u, 0u, 0u, 0u}; vr[i] = (u32x4){0u, 0u, 0u, 0u}; }
        }
        float kf[32]; float ss = 0.f;
#pragma unroll
        for (int i = 0; i < 4; ++i)
#pragma unroll
            for (int e = 0; e < 4; ++e) { const unsigned wd = kr[i][e]; kf[8 * i + 2 * e] = bflo(wd); kf[8 * i + 2 * e + 1] = bfhi(wd); }
#pragma unroll
        for (int i = 0; i < 32; ++i) ss += kf[i] * kf[i];
        ss += __shfl_xor(ss, 1);
        const float rstd = 1.0f / sqrtf(ss * (1.0f / 64.0f) + EPS);
        LAS unsigned char* kdst = lds + AT_KS + row * AT_KROW + half * 64;
#pragma unroll
        for (int i = 0; i < 4; ++i) { u32x4 o;
#pragma unroll
            for (int e = 0; e < 4; ++e) { const int d = half * 32 + 8 * i + 2 * e; o[e] = pk2(kf[8 * i + 2 * e] * rstd * k_gain[d], kf[8 * i + 2 * e + 1] * rstd * k_gain[d + 1]); }
            *(LAS u32x4*)(kdst + 16 * i) = o; }
        LAS unsigned char* vdst = lds + AT_VT + row * AT_VROW + half * 64;
#pragma unroll
        for (int i = 0; i < 4; ++i) *(LAS u32x4*)(vdst + 16 * i) = vr[i];
        if (tid < 128) ((LAS float*)(lds + AT_BT))[tid] = rel_bias[t5_bucket(tid) * NH + h] * LOG2E;
    }
    const int qrow = nb * 128 + w * 16 + c;
    bf16x8 qf[2];
    {
        const u32x4 q0 = *(const u32x4*)(Q + (size_t)qrow * AW + h * 64 + 8 * g), q1 = *(const u32x4*)(Q + (size_t)qrow * AW + h * 64 + 32 + 8 * g);
        float f0[8], f1[8]; float ss = 0.f;
#pragma unroll
        for (int e = 0; e < 4; ++e) { f0[2 * e] = bflo(q0[e]); f0[2 * e + 1] = bfhi(q0[e]); f1[2 * e] = bflo(q1[e]); f1[2 * e + 1] = bfhi(q1[e]); }
#pragma unroll
        for (int e = 0; e < 8; ++e) ss += f0[e] * f0[e] + f1[e] * f1[e];
        ss += __shfl_xor(ss, 16); ss += __shfl_xor(ss, 32);
        const float rs = (1.0f / sqrtf(ss * (1.0f / 64.0f) + EPS)) * (0.125f * LOG2E);
        u32x4 p0, p1;
#pragma unroll
        for (int e = 0; e < 4; ++e) { const int d = 8 * g + 2 * e; p0[e] = pk2(f0[2 * e] * rs * q_gain[d], f0[2 * e + 1] * rs * q_gain[d + 1]); p1[e] = pk2(f1[2 * e] * rs * q_gain[32 + d], f1[2 * e + 1] * rs * q_gain[32 + d + 1]); }
        qf[0] = __builtin_bit_cast(bf16x8, p0); qf[1] = __builtin_bit_cast(bf16x8, p1);
    }
    const float sink2 = sinks[h] * LOG2E;
    LDS_WAIT(); __syncthreads();
    f32x4 sv[9];
    const LAS float* bt = (const LAS float*)(lds + AT_BT);
    float mx = sink2;
#pragma unroll
    for (int kb = 0; kb < 9; ++kb) {
        const int krow = 16 * (w + kb) + c;
        const bf16x8 k0 = *(const LAS bf16x8*)(lds + AT_KS + krow * AT_KROW + 16 * g), k1 = *(const LAS bf16x8*)(lds + AT_KS + krow * AT_KROW + 64 + 16 * g);
        f32x4 a = {0.f, 0.f, 0.f, 0.f};
        a = __builtin_amdgcn_mfma_f32_16x16x32_bf16(k0, qf[0], a, 0, 0, 0);
        a = __builtin_amdgcn_mfma_f32_16x16x32_bf16(k1, qf[1], a, 0, 0, 0);
#pragma unroll
        for (int r = 0; r < 4; ++r) {
            const int dist = 128 + c - 16 * kb - 4 * g - r;
            const int j = 16 * (w + kb) + 4 * g + r;
            const bool ok = (dist >= 0) && (dist < 128) && (nb > 0 || j >= 128);
            const float lg = a[r] + bt[dist & 127];
            a[r] = ok ? lg : -1e30f;
            mx = fmaxf(mx, a[r]);
        }
        sv[kb] = a;
    }
    mx = fmaxf(mx, __shfl_xor(mx, 16)); mx = fmaxf(mx, __shfl_xor(mx, 32));
    float lsum = 0.f;
#pragma unroll
    for (int kb = 0; kb < 9; ++kb)
#pragma unroll
        for (int r = 0; r < 4; ++r) { const float p = __builtin_amdgcn_exp2f(sv[kb][r] - mx); sv[kb][r] = p; lsum += p; }
    lsum += __shfl_xor(lsum, 16); lsum += __shfl_xor(lsum, 32);
    lsum += __builtin_amdgcn_exp2f(sink2 - mx);
    const float inv = 1.0f / lsum;
    f32x4 oacc[4];
#pragma unroll
    for (int db = 0; db < 4; ++db) oacc[db] = (f32x4){0.f, 0.f, 0.f, 0.f};
    LAS unsigned char* vtr = lds + AT_VT + (4 * g + (c >> 2)) * AT_VROW + 8 * (c & 3);
#pragma unroll
    for (int ks = 0; ks < 5; ++ks) {
        u32x4 pw; pw.x = pk2(sv[2 * ks][0], sv[2 * ks][1]); pw.y = pk2(sv[2 * ks][2], sv[2 * ks][3]);
        if (ks < 4) { pw.z = pk2(sv[2 * ks + 1][0], sv[2 * ks + 1][1]); pw.w = pk2(sv[2 * ks + 1][2], sv[2 * ks + 1][3]); } else { pw.z = 0u; pw.w = 0u; }
        const bf16x8 pf = __builtin_bit_cast(bf16x8, pw);
        const int kb0 = w + 2 * ks, kb1r = w + 2 * ks + 1, kb1 = kb1r > 15 ? 15 : kb1r;
#pragma unroll
        for (int db = 0; db < 4; ++db) {
            const at_v4i16 lo = __builtin_amdgcn_ds_read_tr16_b64_v4i16((LAS at_v4i16*)(vtr + kb0 * (16 * AT_VROW) + 32 * db)), hi = __builtin_amdgcn_ds_read_tr16_b64_v4i16((LAS at_v4i16*)(vtr + kb1 * (16 * AT_VROW) + 32 * db));
            const u32x2 l2 = __builtin_bit_cast(u32x2, lo), h2 = __builtin_bit_cast(u32x2, hi);
            const u32x4 vw = {l2.x, l2.y, h2.x, h2.y};
            oacc[db] = __builtin_amdgcn_mfma_f32_16x16x32_bf16(__builtin_bit_cast(bf16x8, vw), pf, oacc[db], 0, 0, 0);
        }
    }
#pragma unroll
    for (int db = 0; db < 4; ++db) { u32x2 ow; ow.x = pk2(oacc[db][0] * inv, oacc[db][1] * inv); ow.y = pk2(oacc[db][2] * inv, oacc[db][3] * inv);
        *(u32x2*)(O + (size_t)qrow * AW + h * 64 + 16 * db + 4 * g) = ow; }
    LDS_WAIT(); __syncthreads();
}

struct Args { const float* in[21]; float* out; unsigned char* ws; };
__global__ void __launch_bounds__(512, 2) mega_fwd(Args args) {
    extern __shared__ __attribute__((aligned(16))) unsigned char lds_raw[];
    LAS unsigned char* lds = (LAS unsigned char*)lds_raw;
    const int tid = threadIdx.x, lane = tid & 63, wave = __builtin_amdgcn_readfirstlane(tid >> 6);
    const int G = gridDim.x, bx = blockIdx.x;
    const int vcu = (G % 8 == 0) ? (bx % 8) * (G / 8) + bx / 8 : bx;
    const int gw = vcu * 8 + wave, NGW = G * 8;
    Ptrs P;
    P.x = args.in[0]; P.c = args.in[1]; P.w_ada = args.in[2]; P.b_ada = args.in[3]; P.g_ffn1 = args.in[4]; P.w_gu1 = args.in[5]; P.w_d1 = args.in[6]; P.g_mix = args.in[7];
    P.w_in = args.in[8]; P.pool_mix = args.in[9]; P.pool_scale = args.in[10]; P.w_pu = args.in[11]; P.q_gain = args.in[12]; P.k_gain = args.in[13]; P.sinks = args.in[14];
    P.rel_bias = args.in[15]; P.w_au = args.in[16]; P.w_o = args.in[17]; P.g_ffn2 = args.in[18]; P.w_gu2 = args.in[19]; P.w_d2 = args.in[20]; P.out = args.out; P.ws = args.ws;
    unsigned char* ws = args.ws;
    unsigned* ctl = (unsigned*)(ws + WS_CTL);
    float* modp = (float*)(ws + WS_MODP); float* mod = (float*)(ws + WS_MOD); float* bwin = (float*)(ws + WS_BWIN); float* bwgu = (float*)(ws + WS_BWGU); float* rowp = (float*)(ws + WS_ROWP);
    bf16* Hb = (bf16*)(ws + WS_H); bf16* ACT = (bf16*)(ws + WS_ACT);
    float* Ub = (float*)(ws + WS_U); bf16* Qb = (bf16*)(ws + WS_Q); bf16* Kb = (bf16*)(ws + WS_K); bf16* Vb = (bf16*)(ws + WS_V);
    bf16* GA = (bf16*)(ws + WS_GA); bf16* GB = (bf16*)(ws + WS_GB); bf16* POOLED = (bf16*)(ws + WS_POOLED); bf16* MIXED = (bf16*)(ws + WS_MIXED); bf16* ATT = (bf16*)(ws + WS_ATT); bf16* MERGED = (bf16*)(ws + WS_MERGED); bf16* HX = (bf16*)(ws + WS_HX);

    volatile LAS unsigned* MISC = (volatile LAS unsigned*)(lds + MISC_OFF);
    if (tid < 64) ((LAS unsigned*)(lds + RING_BYTES))[tid + 64] = 0u;
    __syncthreads();
    XcdBarrier bar = xcd_barrier_post(ctl + CW_BAR, MISC + 8);
#define GRID_BAR() xcd_barrier(bar)

    if ((PHASE_MASK >> 0) & 1) gemv_partials(P.c, P.w_ada, modp, G, wave, lane);
    GRID_BAR();
    if ((PHASE_MASK >> 1) & 1) {
        mod_reduce(modp, P.b_ada, mod);
        LAS float* ta = (LAS float*)lds; LAS float* tb = ta + D;
        { const int col = 4 * tid; const f32x4 shv = mod_vec4(modp, P.b_ada, 0, col), scv = mod_vec4(modp, P.b_ada, 1, col), g = *(const f32x4*)(P.g_ffn1 + col);
          *(LAS f32x4*)(ta + col) = g * (scv + 1.0f); *(LAS f32x4*)(tb + col) = shv;
 }
        LDS_WAIT(); __syncthreads();
        normmod_phase(P.x, ta, tb, Hb, gw, NGW, lane);
        LDS_WAIT(); __syncthreads();
        convert_weights(P, lds, 0, CV_I_GU1, gw, NGW, wave, lane, nullptr, nullptr);
    }
    GRID_BAR();
    if ((PHASE_MASK >> 2) & 1) {
        const int kslot = ((bx >> 3) * 6) >> 5;
        LAS float* sh3 = (LAS float*)(lds + TAB_OFF); LAS float* sh6 = sh3 + D;
        *(LAS f32x4*)(sh3 + 4 * tid) = *(const f32x4*)(mod + 3 * D + 4 * tid); *(LAS f32x4*)(sh6 + 4 * tid) = *(const f32x4*)(mod + 6 * D + 4 * tid);
        LDS_WAIT(); __syncthreads();
        pg8::EpiSwiglu<false> E{ACT, FF, nullptr, nullptr};
        if (kslot > 0) { pg8::Sched Sc; Sc.init(S, 2 * FF, G, bx, Hb, ws + WS_WGU1, D, D); Sc.mode = 1; Sc.split_round = 5; Sc.split_mod = 128; Sc.r_hi = kslot;
            pg8::gemm_phase<pg8::EpiSwiglu<false>, true, true>(lds, D, D, D, Sc, E, ctl + CW_PANEL); }
        convert_weights(P, lds, CV_I_GU1, CV_NITEMS, gw, NGW, wave, lane, sh3, sh6);
        asm volatile("s_waitcnt vmcnt(0)" ::: "memory"); __syncthreads();
        if (tid == 0) { __builtin_amdgcn_fence(__ATOMIC_RELEASE, "agent"); asm volatile("s_waitcnt vmcnt(0)" ::: "memory");
            __hip_atomic_fetch_add(ctl + CW_CVDONE, 1u, __ATOMIC_RELAXED, __HIP_MEMORY_SCOPE_AGENT); }
        { pg8::Sched Sc; Sc.init(S, 2 * FF, G, bx, Hb, ws + WS_WGU1, D, D); Sc.mode = 1; Sc.split_round = 5; Sc.split_mod = 128; Sc.r_lo = kslot;
            pg8::gemm_phase<pg8::EpiSwiglu<false>, true, true>(lds, D, D, D, Sc, E, ctl + CW_PANEL); }
    }
    if ((PHASE_MASK >> 3) & 1) {
        pg8::Sched Sc; Sc.init(S, D, G, bx, ACT, ws + WS_WD1, FF, FF); Sc.mode = 2; pg8::EpiResid<true, true> E{P.x, P.out, mod + 2 * D, P.g_mix, mod + 4 * D, HX, rowp};
        wait_counter_ge(ctl + CW_CVDONE, (unsigned)G);
        bias_reduce((const float*)(ws + WS_BPIN), (const float*)(ws + WS_BPGU), bwin, bwgu);
        { pg8::Unit u0; (void)Sc.next(0, u0); wait_counter_ge(ctl + CW_PANEL + 64 * u0.pm, 44u * 8u * 2u); }
        pg8::gemm_phase<pg8::EpiResid<true, true>, false>(lds, FF, FF, FF, Sc, E);
    }
    GRID_BAR();
    if ((PHASE_MASK >> 4) & 1) {
        pg8::Sched Sc; Sc.init(S, INW, G, bx, HX, ws + WS_WIN, D, D); Sc.r_hi = 3; pg8::EpiIn E{Ub, Qb, Kb, Vb, GA, GB, rowp, bwin};
        pg8::gemm_phase<pg8::EpiIn, true>(lds, D, D, D, Sc, E);
    }
    GRID_BAR();
    if ((PHASE_MASK >> 5) & 1) {
        if (bx < 64) {
            pg8::Sched Sc; Sc.init(S, INW, G, bx, HX, ws + WS_WIN, D, D); Sc.r_lo = 3; Sc.split_round = 3; Sc.split_mod = 32; pg8::EpiIn E{Ub, Qb, Kb, Vb, GA, GB, rowp, bwin};
            pg8::gemm_phase<pg8::EpiIn, true>(lds, D, D, D, Sc, E);
        } else if (bx < 192) {
            pg8::Sched Sc; Sc.init(S, PW, 128, bx - 64, POOLED, ws + WS_WPM, PW, 256, 256 * 2);
            pg8::Unit u0; (void)Sc.next(0, u0);
            pooled_tile(Ub, POOLED, u0.pm, u0.pn);
            asm volatile("s_waitcnt vmcnt(0)" ::: "memory"); __syncthreads();
            if (tid == 0) { __builtin_amdgcn_fence(__ATOMIC_ACQUIRE, "agent"); asm volatile("s_waitcnt vmcnt(0)" ::: "memory"); }
            __syncthreads();
            pg8::EpiPoolMix E{MIXED, P.pool_scale};
            pg8::gemm_phase<pg8::EpiPoolMix, false>(lds, 256, PW, 256, Sc, E);
        }
        for (;;) {
            if (tid == 0) MISC[0] = __hip_atomic_fetch_add(ctl + CW_QHEAD, 1u, __ATOMIC_RELAXED, __HIP_MEMORY_SCOPE_AGENT);
            __syncthreads();
            const int uid = (int)MISC[0];
            __syncthreads();
            if (uid >= 1024) break;
            const int hh = uid & 7, grp = uid >> 3, kvh = grp & 1, nb = grp >> 1;
            attn_unit(nb, kvh * 8 + hh, Qb, Kb, Vb, ATT, P.q_gain, P.k_gain, P.sinks, P.rel_bias, lds);
        }
    }
    GRID_BAR();
    if ((PHASE_MASK >> 6) & 1) {
        pg8::Sched Sc; Sc.init(S, D, G, bx, MIXED, ws + WS_WPU, PW, PW, 0, ATT, ws + WS_WAU); pg8::EpiMerge E{GA, GB, MERGED};
        pg8::gemm_phase<pg8::EpiMerge, false>(lds, PW, PW, PW, Sc, E);
    }
    GRID_BAR();
    if ((PHASE_MASK >> 7) & 1) {
        pg8::Sched Sc; Sc.init(S, D, G, bx, MERGED, ws + WS_WO, D, D); pg8::EpiResid<true, false> E{P.out, P.out, mod + 5 * D, P.g_ffn2, mod + 7 * D, Hb, rowp};
        pg8::gemm_phase<pg8::EpiResid<true, false>, false>(lds, D, D, D, Sc, E);
    }
    GRID_BAR();
    if ((PHASE_MASK >> 8) & 1) {
        pg8::Sched Sc; Sc.init(S, 2 * FF, G, bx, Hb, ws + WS_WGU2, D, D); Sc.mode = 1; Sc.split_round = 5; Sc.split_mod = 128; pg8::EpiSwiglu<true> E{ACT, FF, rowp, bwgu};
        pg8::gemm_phase<pg8::EpiSwiglu<true>, true, true>(lds, D, D, D, Sc, E, ctl + CW_PANEL + 32 * 64);
    }
    if ((PHASE_MASK >> 9) & 1) {
        pg8::Sched Sc; Sc.init(S, D, G, bx, ACT, ws + WS_WD2, FF, FF); Sc.mode = 2; pg8::EpiResid<false, true> E{P.out, P.out, mod + 8 * D, nullptr, nullptr, nullptr, nullptr};
        { pg8::Unit u0; (void)Sc.next(0, u0); wait_counter_ge(ctl + CW_PANEL + 32 * 64 + 64 * u0.pm, 44u * 8u * 2u); }
        pg8::gemm_phase<pg8::EpiResid<false, true>, false>(lds, FF, FF, FF, Sc, E);
    }
#undef GRID_BAR
}

extern "C" void kernel_launch(void* const* d_in, const int* in_sizes, int n_in, void* d_out, int out_size, void* d_ws, size_t ws_size, hipStream_t stream) {
    static int grid = 0;
    if (grid == 0) {
        if (n_in != 21 || in_sizes[0] != S * D || out_size != S * D || ws_size < WS_END) { fprintf(stderr, "kernel_launch: unexpected shapes (n_in %d, in0 %d, out %d, ws %zu < %zu)\n", n_in, n_in > 0 ? in_sizes[0] : -1, out_size, ws_size, (size_t)WS_END); grid = -1; return; }
        int dev = 0, cus = 0, per_cu = 0;
        if (hipGetDevice(&dev) != hipSuccess || hipDeviceGetAttribute(&cus, hipDeviceAttributeMultiprocessorCount, dev) != hipSuccess) { grid = -1; return; }
        if (hipFuncSetAttribute((const void*)mega_fwd, hipFuncAttributeMaxDynamicSharedMemorySize, LDS_BYTES) != hipSuccess) { fprintf(stderr, "kernel_launch: hipFuncSetAttribute failed\n"); grid = -1; return; }
        if (hipOccupancyMaxActiveBlocksPerMultiprocessor(&per_cu, (const void*)mega_fwd, 512, LDS_BYTES) != hipSuccess || per_cu < 1) { fprintf(stderr, "kernel_launch: occupancy query says %d blocks per CU\n", per_cu); grid = -1; return; }
        (void)hipGetLastError();
        grid = cus;
        if (grid != 256) { fprintf(stderr, "kernel_launch: built for a 256-CU device, found %d CUs\n", cus); grid = -1; return; }
    }
    if (grid < 0) return;
    (void)hipMemsetAsync((char*)d_ws + WS_CTL, 0, CTL_ZERO_BYTES, stream);
    Args a{};
    for (int i = 0; i < 21; ++i) a.in[i] = (const float*)d_in[i];
    a.out = (float*)d_out; a.ws = (unsigned char*)d_ws;
    void* kargs[] = {&a};
    hipError_t e = hipLaunchCooperativeKernel((const void*)mega_fwd, dim3(grid), dim3(512), kargs, LDS_BYTES, stream);
    if (e != hipSuccess) fprintf(stderr, "kernel_launch: cooperative launch failed: %s (grid %d)\n", hipGetErrorString(e), grid);
}
```
